# Optimizing an MI355X kernel written in HIP

```python
import math
import jax
import jax.numpy as jnp
from jax import lax
import numpy as np

D_MODEL = 2048
BATCH = 8
SEQ = 2048
DEPTH = 2

N_MIXERS = 2
N_EVEN = (DEPTH + 1) // 2
N_ODD = DEPTH // 2
CONV_WIDTH = 3
N_HEADS = 16
HEAD_DIM = D_MODEL // N_HEADS
MOBA_BLOCK = 256
MOBA_TOPK = 3
Q_CHUNK = 16
ROPE_THETA = 10000.0
D_FF_DENSE = 5632
N_EXPERTS = 8
EXPERT_TOPK = 2
D_FF_EXPERT = 7168
EXPERT_ROW_BLOCK = 512
NORM_EPS = 1e-6
NEG_INF = -1e30
MOD_STD = 0.2

kernel_name = "hybrid_shortconv_moba_moe_adaln"


def rms_norm(x, gain):
    xf = x.astype(jnp.float32)
    y = xf * lax.rsqrt(jnp.mean(xf * xf, axis=-1, keepdims=True) + NORM_EPS)
    return (y * gain.astype(jnp.float32)).astype(x.dtype)


def modulate(h, shift, scale):
    return h * (1.0 + scale[:, None, :]) + shift[:, None, :]


def swiglu(h, w_gate, w_up, w_down):
    return (jax.nn.silu(h @ w_gate) * (h @ w_up)) @ w_down


def rope(x, positions):
    half = HEAD_DIM // 2
    inv_freq = jnp.exp(-math.log(ROPE_THETA) * jnp.arange(half, dtype=jnp.float32) / half)
    ang = positions.astype(jnp.float32)[:, None] * inv_freq[None, :]
    cos, sin = jnp.cos(ang), jnp.sin(ang)
    xf = x.astype(jnp.float32)
    x1, x2 = xf[..., :half], xf[..., half:]
    return jnp.concatenate([x1 * cos - x2 * sin, x2 * cos + x1 * sin], axis=-1).astype(x.dtype)


def short_conv_mixer(h, w_in, conv_w, w_out):
    b_gate, c_gate, v = jnp.split(h @ w_in, 3, axis=-1)
    u = c_gate * v
    u = lax.conv_general_dilated(
        u, conv_w[:, None, :].astype(u.dtype), window_strides=(1,),
        padding=[(CONV_WIDTH - 1, 0)], dimension_numbers=("NWC", "WIO", "NWC"),
        feature_group_count=u.shape[-1])
    return (b_gate * u) @ w_out


def moba_attention(h, w_qkv, q_gain, k_gain, w_out):
    B, S, _ = h.shape
    qkv = (h @ w_qkv).reshape(B, S, 3, N_HEADS, HEAD_DIM)
    q, k, v = (jnp.transpose(qkv[:, :, i], (0, 2, 1, 3)) for i in range(3))
    positions = jnp.arange(S)
    q = rope(rms_norm(q, q_gain), positions)
    k = rope(rms_norm(k, k_gain), positions)
    n_blk = -(-S // MOBA_BLOCK)
    pad = n_blk * MOBA_BLOCK - S
    kb = jnp.pad(k, ((0, 0), (0, 0), (0, pad), (0, 0))).reshape(B, N_HEADS, n_blk, MOBA_BLOCK, HEAD_DIM)
    vb = jnp.pad(v, ((0, 0), (0, 0), (0, pad), (0, 0))).reshape(B, N_HEADS, n_blk, MOBA_BLOCK, HEAD_DIM)
    k_mean = jnp.mean(kb.astype(jnp.float32), axis=3)
    n_sel = min(MOBA_TOPK, n_blk - 1)
    scale = HEAD_DIM ** -0.5
    n_chunks = S // Q_CHUNK
    q_chunks = q.reshape(B, N_HEADS, n_chunks, Q_CHUNK, HEAD_DIM).transpose(2, 0, 1, 3, 4)
    b_idx = jnp.arange(B)[:, None, None, None]
    h_idx = jnp.arange(N_HEADS)[None, :, None, None]
    blk_ids = jnp.arange(n_blk)
    key_off = jnp.arange(MOBA_BLOCK)

    def attend_chunk(args):
        q_c, c_idx = args
        q_pos = c_idx * Q_CHUNK + jnp.arange(Q_CHUNK)
        own = (c_idx * Q_CHUNK) // MOBA_BLOCK
        k_own = lax.dynamic_index_in_dim(kb, own, axis=2, keepdims=False)
        v_own = lax.dynamic_index_in_dim(vb, own, axis=2, keepdims=False)
        s_own = jnp.einsum("bhqd,bhkd->bhqk", q_c, k_own).astype(jnp.float32) * scale
        s_own = jnp.where(own * MOBA_BLOCK + key_off[None, :] <= q_pos[:, None], s_own, NEG_INF)
        if n_sel == 0:
            p_own = jax.nn.softmax(s_own, axis=-1).astype(v_own.dtype)
            return jnp.einsum("bhqk,bhkd->bhqd", p_own, v_own)
        gate = jnp.einsum("bhqd,bhnd->bhqn", q_c.astype(jnp.float32), k_mean)
        gate = jnp.where(blk_ids < own, gate, NEG_INF)
        _, sel = lax.top_k(gate, n_sel)
        sel_ok = sel < own
        k_sel = kb[b_idx, h_idx, sel]
        v_sel = vb[b_idx, h_idx, sel]
        s_sel = jnp.einsum("bhqd,bhqnkd->bhqnk", q_c, k_sel).astype(jnp.float32) * scale
        s_sel = jnp.where(sel_ok[..., None], s_sel, NEG_INF)
        s_all = jnp.concatenate([s_sel.reshape(B, N_HEADS, Q_CHUNK, n_sel * MOBA_BLOCK), s_own], axis=-1)
        p = jax.nn.softmax(s_all, axis=-1).astype(v_own.dtype)
        p_sel = p[..., :n_sel * MOBA_BLOCK].reshape(B, N_HEADS, Q_CHUNK, n_sel, MOBA_BLOCK)
        p_own = p[..., n_sel * MOBA_BLOCK:]
        return (jnp.einsum("bhqnk,bhqnkd->bhqd", p_sel, v_sel)
                + jnp.einsum("bhqk,bhkd->bhqd", p_own, v_own))

    o = lax.map(attend_chunk, (q_chunks, jnp.arange(n_chunks)))
    o = o.transpose(1, 0, 3, 2, 4).reshape(B, S, D_MODEL)
    return o @ w_out


def moe_swiglu(h, w_router, b_router, w_gate, w_up, w_down):
    B, S, D = h.shape
    tok = h.reshape(B * S, D)
    n_tok = B * S
    n_assign = n_tok * EXPERT_TOPK
    logits = (tok @ w_router).astype(jnp.float32) + b_router.astype(jnp.float32)
    top_logit, top_idx = lax.top_k(logits, EXPERT_TOPK)
    top_w = jax.nn.softmax(top_logit, axis=-1)
    flat_e = top_idx.reshape(-1)
    flat_tok = jnp.repeat(jnp.arange(n_tok, dtype=jnp.int32), EXPERT_TOPK)
    flat_w = top_w.reshape(-1)
    counts = jnp.bincount(flat_e, length=N_EXPERTS)
    padded = (counts + EXPERT_ROW_BLOCK - 1) // EXPERT_ROW_BLOCK * EXPERT_ROW_BLOCK
    pad_end = jnp.cumsum(padded)
    pad_start = pad_end - padded
    start = jnp.cumsum(counts) - counts
    order = jnp.argsort(flat_e)
    sorted_e = flat_e[order]
    dest = pad_start[sorted_e] + jnp.arange(n_assign) - start[sorted_e]
    n_blocks = -(-n_assign // EXPERT_ROW_BLOCK) + N_EXPERTS
    n_rows = n_blocks * EXPERT_ROW_BLOCK
    row_tok = jnp.zeros((n_rows,), jnp.int32).at[dest].set(flat_tok[order])
    row_w = jnp.zeros((n_rows,), jnp.float32).at[dest].set(flat_w[order])
    block_e = jnp.minimum(
        jnp.searchsorted(pad_end, jnp.arange(n_blocks) * EXPERT_ROW_BLOCK, side="right"),
        N_EXPERTS - 1)
    xs = tok[row_tok].reshape(n_blocks, EXPERT_ROW_BLOCK, D)

    def expert_block(args):
        x_b, e = args
        return swiglu(x_b, w_gate[e], w_up[e], w_down[e])

    ys = lax.map(expert_block, (xs, block_e)).reshape(n_rows, D)
    out = jnp.zeros_like(tok).at[row_tok].add(ys * row_w[:, None].astype(ys.dtype))
    return out.reshape(B, S, D)


def setup_inputs(seed: int = 0) -> dict:
    key = jax.random.key(seed)
    ks = jax.random.split(key, 24)
    D = D_MODEL

    def nrm(k, shape, std):
        return jax.random.normal(k, shape, jnp.float32) * std

    return {
        "x": nrm(ks[0], (BATCH, SEQ, D), 1.0),
        "c": nrm(ks[1], (BATCH, D), 1.0),
        "mod_w": nrm(ks[2], (DEPTH, D, 6 * D), MOD_STD * D ** -0.5),
        "mod_b": nrm(ks[3], (DEPTH, 6 * D), 0.02),
        "norm_mix": 1.0 + nrm(ks[4], (DEPTH, D), 0.05),
        "norm_ffn": 1.0 + nrm(ks[5], (DEPTH, D), 0.05),
        "conv_in": nrm(ks[6], (N_EVEN, D, 3 * D), D ** -0.5),
        "conv_w": nrm(ks[7], (N_EVEN, CONV_WIDTH, D), CONV_WIDTH ** -0.5),
        "conv_out": nrm(ks[8], (N_EVEN, D, D), D ** -0.5),
        "ffn_gate": nrm(ks[9], (N_EVEN, D, D_FF_DENSE), D ** -0.5),
        "ffn_up": nrm(ks[10], (N_EVEN, D, D_FF_DENSE), D ** -0.5),
        "ffn_down": nrm(ks[11], (N_EVEN, D_FF_DENSE, D), D_FF_DENSE ** -0.5),
        "qkv_w": nrm(ks[12], (N_ODD, D, 3 * D), D ** -0.5),
        "q_norm": 1.0 + nrm(ks[13], (N_ODD, HEAD_DIM), 0.05),
        "k_norm": 1.0 + nrm(ks[14], (N_ODD, HEAD_DIM), 0.05),
        "attn_out": nrm(ks[15], (N_ODD, D, D), D ** -0.5),
        "router_w": nrm(ks[16], (N_ODD, D, N_EXPERTS), D ** -0.5),
        "router_b": nrm(ks[17], (N_ODD, N_EXPERTS), 0.01),
        "exp_gate": nrm(ks[18], (N_ODD, N_EXPERTS, D, D_FF_EXPERT), D ** -0.5),
        "exp_up": nrm(ks[19], (N_ODD, N_EXPERTS, D, D_FF_EXPERT), D ** -0.5),
        "exp_down": nrm(ks[20], (N_ODD, N_EXPERTS, D_FF_EXPERT, D), D_FF_EXPERT ** -0.5),
    }


def reference(x, c, mod_w, mod_b, norm_mix, norm_ffn, conv_in, conv_w, conv_out,
              ffn_gate, ffn_up, ffn_down, qkv_w, q_norm, k_norm, attn_out,
              router_w, router_b, exp_gate, exp_up, exp_down):
    c_act = jax.nn.silu(c)
    for i in range(DEPTH):
        j = i // N_MIXERS
        mod = c_act @ mod_w[i] + mod_b[i]
        sh_m, sc_m, g_m, sh_f, sc_f, g_f = jnp.split(mod, 6, axis=-1)
        h = modulate(rms_norm(x, norm_mix[i]), sh_m, sc_m)
        if i % N_MIXERS == 0:
            y = short_conv_mixer(h, conv_in[j], conv_w[j], conv_out[j])
        else:
            y = moba_attention(h, qkv_w[j], q_norm[j], k_norm[j], attn_out[j])
        x = x + g_m[:, None, :] * y
        h = modulate(rms_norm(x, norm_ffn[i]), sh_f, sc_f)
        if i % 2 == 0:
            y = swiglu(h, ffn_gate[j], ffn_up[j], ffn_down[j])
        else:
            y = moe_swiglu(h, router_w[j], router_b[j], exp_gate[j], exp_up[j], exp_down[j])
        x = x + g_f[:, None, :] * y
    return x
```

```cpp
#include <hip/hip_runtime.h>
#include <cstdio>
#include <cstdint>

#ifndef MK_PER_PHASE
#define MK_PER_PHASE 0
#endif

#ifndef MOE_F8
#define MOE_F8 1
#endif
#ifndef F8_FFN_GU
#define F8_FFN_GU 0
#endif
#ifndef F8_FFN_DN
#define F8_FFN_DN 1
#endif
#ifndef F8_QKV
#define F8_QKV 1
#endif
#ifndef F8_AOUT
#define F8_AOUT 1
#endif
#ifndef QK_FUSED
#define QK_FUSED 1
#endif
#ifndef X_BF16
#define X_BF16 1
#endif
#ifndef I8_CONVIN
#define I8_CONVIN 1
#endif
#ifndef I8_FFN_GU
#define I8_FFN_GU 1
#endif
#ifndef I8_QKV
#define I8_QKV 1
#endif
#ifndef I8_MOE_GU
#define I8_MOE_GU 1
#endif
#define LAS __attribute__((address_space(3)))
#define GAS __attribute__((address_space(1)))
typedef unsigned short bf16_t;
typedef short bf16x8 __attribute__((ext_vector_type(8)));
typedef short s16x4 __attribute__((ext_vector_type(4)));
typedef float f32x4 __attribute__((ext_vector_type(4)));
typedef float f32x2 __attribute__((ext_vector_type(2)));
typedef float f32x16 __attribute__((ext_vector_type(16)));
typedef unsigned u32x4 __attribute__((ext_vector_type(4)));
typedef unsigned u32x2 __attribute__((ext_vector_type(2)));
typedef int i32x4_ __attribute__((ext_vector_type(4)));

constexpr int DM = 2048, NB = 8, SEQ = 2048, MTOK = NB * SEQ;
constexpr int NH = 16, HD = 128, MBLK = 256, NBLK = SEQ / MBLK, TOPK = 3;
constexpr int FF = 5632, NE = 8, FFE = 7168;
constexpr int MT_MAX = 2 * MTOK / 256 + NE;
constexpr int MROWS = MT_MAX * 256;
constexpr float NORM_EPS = 1e-6f;
constexpr float W_SCALE = 64.f, HS_SCALE = 16.f, HID_SCALE = 8.f, O_SCALE = 64.f;
constexpr float WI8_CLIP = 4.5f;
enum { WQ_CONVIN = 0, WQ_FGATE, WQ_FUP, WQ_QKV, WQ_EGATE, WQ_EUP, WQ_N };
constexpr int MD_CONVIN = I8_CONVIN ? 2 : 0, MD_FFN_GU = I8_FFN_GU ? 2 : (F8_FFN_GU ? 1 : 0), MD_QKV = I8_QKV ? 2 : (F8_QKV ? 1 : 0), MD_MOE_GU = I8_MOE_GU ? 2 : (MOE_F8 ? 1 : 0);

constexpr size_t MiB = 1u << 20;
constexpr size_t WS_CTL = 0, CTL_ZERO_BYTES = 1 * MiB;
constexpr size_t WS_MOD = 2 * MiB;
constexpr size_t WS_KMEAN = 3 * MiB;
constexpr size_t WS_ROUTE = 4 * MiB;
constexpr size_t WS_CNT = 5 * MiB;
constexpr size_t WS_RS = 7 * MiB;
constexpr size_t WS_WSC = 5 * MiB + 32768;
constexpr size_t WS_RS2 = 7 * MiB + 262144;
constexpr size_t WS_ROPE = 6 * MiB;
constexpr size_t WS_W1 = 8 * MiB;
constexpr size_t WS_W2 = 32 * MiB;
constexpr size_t WS_W3 = 40 * MiB;
constexpr size_t WS_W4 = 84 * MiB;
constexpr size_t WS_W5 = 106 * MiB;
constexpr size_t WS_W6 = 130 * MiB;
constexpr size_t WS_W7 = 138 * MiB;
constexpr size_t WS_W8 = 586 * MiB;
constexpr size_t WS_X = 810 * MiB;
constexpr size_t WS_AR = 938 * MiB;
constexpr size_t A_H = 0;
constexpr size_t A_U = 64 * MiB, A_BG = 128 * MiB, A_W = 192 * MiB, A_HID = 256 * MiB;
constexpr size_t A_QKV = 64 * MiB, A_O = 256 * MiB;
constexpr size_t A_HS = 64 * MiB, A_HID2 = 200 * MiB, A_SLAB = 600 * MiB, A_Y = 676 * MiB;
constexpr size_t WS_END = WS_AR + 812 * MiB;
static_assert(A_HS + (size_t)MROWS * DM * 2 <= A_HID2 && A_HID2 + (size_t)MROWS * FFE * 2 <= A_Y && A_Y + (size_t)MROWS * DM * 2 <= 812 * MiB, "arena");
static_assert(A_HID + (size_t)MTOK * FF * 2 <= 812 * MiB && A_QKV + (size_t)MTOK * 6144 * 2 <= A_O, "arena2");
constexpr int CW_BAR = 4096;

constexpr int RING_BYTES = 131072;
constexpr int PHASE_LDS = 143360;
constexpr int MISC_OFF = PHASE_LDS + 320;
constexpr int LDS_BYTES = 147456;

#define RLX_AGENT __ATOMIC_RELAXED, __HIP_MEMORY_SCOPE_AGENT
#define LDS_WAIT() asm volatile("s_waitcnt lgkmcnt(0)" ::: "memory")
#define VM_WAIT() asm volatile("s_waitcnt vmcnt(0)" ::: "memory")
__device__ __forceinline__ unsigned f2bf(float f) { unsigned u = __builtin_bit_cast(unsigned, f); return (u + 0x7fffu + ((u >> 16) & 1u)) >> 16; }
__device__ __forceinline__ unsigned pk2(float lo, float hi) { return f2bf(lo) | (f2bf(hi) << 16); }
__device__ __forceinline__ unsigned cvt_pk_bf16(float lo, float hi) { unsigned r; asm volatile("v_cvt_pk_bf16_f32 %0, %1, %2" : "=v"(r) : "v"(lo), "v"(hi)); return r; }
__device__ __forceinline__ float bf_lo(unsigned w) { return __builtin_bit_cast(float, w << 16); }
__device__ __forceinline__ float bf_hi(unsigned w) { return __builtin_bit_cast(float, w & 0xffff0000u); }
typedef _Float16 f16x2 __attribute__((ext_vector_type(2)));
__device__ __forceinline__ unsigned pk_f16(float lo, float hi) { const f16x2 v = {(_Float16)lo, (_Float16)hi}; return __builtin_bit_cast(unsigned, v); }
__device__ __forceinline__ float hf_lo(unsigned w) { return (float)__builtin_bit_cast(f16x2, w)[0]; }
__device__ __forceinline__ float hf_hi(unsigned w) { return (float)__builtin_bit_cast(f16x2, w)[1]; }
__device__ __forceinline__ int ld_i32_agent(const int* p) { return (int)__hip_atomic_load((const unsigned*)p, RLX_AGENT); }
__device__ __forceinline__ float clamp448(float x) { return __builtin_amdgcn_fmed3f(x, -448.f, 448.f); }
__device__ __forceinline__ unsigned pk4_fp8(float a, float b, float c, float d) {
    int w = __builtin_amdgcn_cvt_pk_fp8_f32(clamp448(a), clamp448(b), 0, false); w = __builtin_amdgcn_cvt_pk_fp8_f32(clamp448(c), clamp448(d), w, true); return (unsigned)w; }
__device__ __forceinline__ unsigned pk4_i8(float a, float b, float c, float d) {
    const int ia = (int)__builtin_rintf(__builtin_amdgcn_fmed3f(a, -127.f, 127.f)), ib = (int)__builtin_rintf(__builtin_amdgcn_fmed3f(b, -127.f, 127.f)), ic = (int)__builtin_rintf(__builtin_amdgcn_fmed3f(c, -127.f, 127.f)), id = (int)__builtin_rintf(__builtin_amdgcn_fmed3f(d, -127.f, 127.f));
    return (unsigned)(ia & 255) | ((unsigned)(ib & 255) << 8) | ((unsigned)(ic & 255) << 16) | ((unsigned)id << 24); }
__device__ __forceinline__ float wave_sum(float v) {
#pragma unroll
    for (int o = 1; o < 64; o <<= 1) v += __shfl_xor(v, o);
    return v;
}

namespace pg8 {
constexpr int BM = 256, BK = 64, HALF = 128, HTB = HALF * BK * 2, STAGE_BYTES = 8 * HTB, NXCD = 8, WGM = 4;
__host__ __device__ __forceinline__ int lds_byte(int r, int c) { const int st = (r >> 4) * 2 + (c >> 5), rr = r & 15, cc = c & 31, ob = rr * 64 + cc * 2; return st * 1024 + (ob ^ (((ob >> 9) & 1) << 5)); }
__host__ __device__ __forceinline__ void stage_rc(int b, int& R, int& C) { const int st = b / 1024, sb = b % 1024, swz = sb ^ (((sb >> 9) & 1) << 5); R = (st >> 1) * 16 + swz / 64; C = (st & 1) * 32 + (swz % 64) / 2; }
__host__ __device__ __forceinline__ int lds_byte8(int r, int cb) { const int st = (r >> 4) * 2 + (cb >> 6), rr = r & 15, ob = rr * 64 + (cb & 63); return st * 1024 + (ob ^ (((ob >> 9) & 1) << 4)); }
__host__ __device__ __forceinline__ void stage_rc8(int b, int& R, int& Cb) { const int st = b / 1024, sb = b % 1024, swz = sb ^ (((sb >> 9) & 1) << 4); R = (st >> 1) * 16 + swz / 64; Cb = (st & 1) * 64 + swz % 64; }
__host__ __device__ __forceinline__ int perm32(int rho) { const int n = rho >> 4, i = rho & 15; return 8 * (i >> 2) + 4 * n + (i & 3); }

struct Unit { int pm, pn, e, k0b, nt, slab; };
struct Gemm { const void* A; const void* Bt; int rowB; size_t estride; };

struct TileOrder {
    int nM, nN, nwg, G, c, ntf; const LAS int* mt_e;
    __device__ __forceinline__ void init(int nM_, int nN_, int G_, int c_, const LAS int* mt, int ntf_) { nM = nM_; nN = nN_; nwg = nM * nN; G = G_; c = c_; mt_e = mt; ntf = ntf_; }
    __device__ __forceinline__ void decode(int L, int& pm, int& pn) const {
        int wgid = L; { const int q = nwg / NXCD, r = nwg % NXCD, xcd = wgid % NXCD, off = wgid / NXCD; wgid = (xcd < r ? xcd * (q + 1) : r * (q + 1) + (xcd - r) * q) + off; }
        const int nig = WGM * nN, gid = wgid / nig, fm = gid * WGM, gsz = (nM - fm) < WGM ? (nM - fm) : WGM;
        pm = fm + ((wgid % nig) % gsz); pn = (wgid % nig) / gsz;
    }
    __device__ __forceinline__ bool next(int i, Unit& u) const {
        const long L = (long)i * G + c; if (L >= nwg) return false;
        int pm, pn; decode((int)L, pm, pn); const int e = mt_e ? mt_e[pm] : 0;
        u = Unit{pm, pn, e, 0, ntf, -1}; return true;
    }
};
template <class Sched> struct SubOrder { Sched S; int off, cnt;
    __device__ __forceinline__ bool next(int i, Unit& u) const { return i < cnt && S.next(i + off, u); } };
__device__ __forceinline__ int moe_split(int n_mt, int nN, int G, int ntf) {
    const int R = (n_mt - 128) * nN; if (R <= 0) return 1;
    int S = 1;
#define MS_TRY(cd) if (R * (cd) <= G && ntf % (cd) == 0 && (ntf / (cd)) % 2 == 0 && ntf / (cd) >= 4) S = (cd);
    MS_TRY(2) MS_TRY(4) MS_TRY(7) MS_TRY(14)
#undef MS_TRY
    return S;
}
struct PieceOrder {
    Unit pc; bool has_pc;
    __device__ __forceinline__ void init(int n_mt, int nN, int G, int c, const int* mt, int ntf) {
        const int S = moe_split(n_mt, nN, G, ntf), R = (n_mt - 128) * nN; has_pc = c < R * S;
        const int q = has_pc ? c : 0, ui = q / S, ks = q % S, ntp = ntf / S, pm = 128 + ui / nN;
        pc = Unit{pm, ui % nN, has_pc ? ld_i32_agent(mt + pm) : 0, ks * ntp * 128, ntp, q};
    }
    __device__ __forceinline__ bool next(int i, Unit& u) const { if (i == 0 && has_pc) { u = pc; return true; } return false; }
};

template <bool I8> __device__ __forceinline__ f32x4 cvacc(const f32x4& a) { if constexpr (I8) return __builtin_convertvector(__builtin_bit_cast(i32x4_, a), f32x4); else return a; }
__device__ __forceinline__ float silu_f(float g) { return g * __builtin_amdgcn_rcpf(1.0f + __builtin_amdgcn_exp2f(-1.4426950408889634f * g)); }

struct EpiResid {
    static constexpr bool PERM = false; static constexpr int NST = 32;
    const float* base; float* out; const float* gate; float sc;
    __device__ __forceinline__ void operator()(const f32x4 (&acc)[2][2][4][2], const Unit& u, int wr, int wc, int fr, int fq) const {
        const int row0 = u.pm * BM + wr * 64 + fr, col0 = u.pn * BM + wc * 32 + 4 * fq;
        const float* g = gate + (size_t)(u.pm >> 3) * (6 * DM) + col0;
        f32x4 gv[2][2];
#pragma unroll
        for (int bj = 0; bj < 2; ++bj)
#pragma unroll
            for (int n = 0; n < 2; ++n) gv[bj][n] = *(const f32x4*)(g + bj * HALF + n * 16) * sc;
#pragma unroll
        for (int ai = 0; ai < 2; ++ai)
#pragma unroll
            for (int m = 0; m < 4; ++m) { const size_t off = (size_t)(row0 + ai * HALF + m * 16) * DM + col0;
#pragma unroll
                for (int bj = 0; bj < 2; ++bj)
#pragma unroll
                    for (int n = 0; n < 2; ++n) { const f32x4 bs = *(const f32x4*)(base + off + bj * HALF + n * 16); *(f32x4*)(out + off + bj * HALF + n * 16) = bs + gv[bj][n] * acc[ai][bj][m][n]; }
                asm volatile("" ::: "memory"); }
    }
};
template <bool BASEF32> struct EpiResidBf {
    static constexpr bool PERM = true; static constexpr int NST = 16;
    const void* base; bf16_t* out; const float* gate; float sc;
    __device__ __forceinline__ void operator()(const f32x4 (&acc)[2][2][4][2], const Unit& u, int wr, int wc, int fr, int fq) const {
        const int row0 = u.pm * BM + wr * 64 + fr, col0 = u.pn * BM + wc * 32 + 8 * fq;
        const float* g = gate + (size_t)(u.pm >> 3) * (6 * DM) + col0;
        f32x4 gv[2][2];
#pragma unroll
        for (int bj = 0; bj < 2; ++bj)
#pragma unroll
            for (int n = 0; n < 2; ++n) gv[bj][n] = *(const f32x4*)(g + bj * HALF + n * 4) * sc;
#pragma unroll
        for (int ai = 0; ai < 2; ++ai)
#pragma unroll
            for (int m = 0; m < 4; ++m) { const size_t off = (size_t)(row0 + ai * HALF + m * 16) * DM + col0;
#pragma unroll
                for (int bj = 0; bj < 2; ++bj) { f32x4 b0, b1;
                    if constexpr (BASEF32) { b0 = *(const f32x4*)((const float*)base + off + bj * HALF); b1 = *(const f32x4*)((const float*)base + off + bj * HALF + 4); }
                    else { const u32x4 w = *(const u32x4*)((const bf16_t*)base + off + bj * HALF); b0 = (f32x4){hf_lo(w.x), hf_hi(w.x), hf_lo(w.y), hf_hi(w.y)}; b1 = (f32x4){hf_lo(w.z), hf_hi(w.z), hf_lo(w.w), hf_hi(w.w)}; }
                    const f32x4 o0 = b0 + gv[bj][0] * acc[ai][bj][m][0], o1 = b1 + gv[bj][1] * acc[ai][bj][m][1];
                    u32x4 ow; ow.x = pk_f16(o0[0], o0[1]); ow.y = pk_f16(o0[2], o0[3]); ow.z = pk_f16(o1[0], o1[1]); ow.w = pk_f16(o1[2], o1[3]);
                    *(u32x4*)(out + off + bj * HALF) = ow; }
                asm volatile("" ::: "memory"); }
    }
};
template <bool F8OUT, bool I8 = false, bool OBLK = false> struct EpiSwiglu {
    static constexpr bool PERM = true; static constexpr int NST = 8;
    void* O; int ldc; float isc, osc; const float* rs; float isc_u;
    mutable int cpm = -1; mutable float rrow[2][4];
    __device__ __forceinline__ static f32x2 sw2(f32x2 gi, f32x2 ui, float ea, float c) {
        const f32x2 t = gi * ea; f32x2 e; e.x = __builtin_amdgcn_exp2f(t.x); e.y = __builtin_amdgcn_exp2f(t.y);
        const f32x2 d = e + 1.0f; f32x2 r; r.x = __builtin_amdgcn_rcpf(d.x); r.y = __builtin_amdgcn_rcpf(d.y);
        return ((gi * ui) * c) * r;
    }
    __device__ __forceinline__ void operator()(const f32x4 (&acc)[2][2][4][2], const Unit& u, int wr, int wc, int fr, int fq) const {
        const int row0 = u.pm * BM + wr * 64 + fr, col0 = u.pn * HALF + wc * 32 + 8 * fq;
        if (!I8) { if (cpm < 0) { cpm = 0;
#pragma unroll
            for (int ai = 0; ai < 2; ++ai)
#pragma unroll
                for (int m = 0; m < 4; ++m) rrow[ai][m] = 1.f; } }
        else if (u.pm != cpm) { cpm = u.pm;
#pragma unroll
            for (int ai = 0; ai < 2; ++ai)
#pragma unroll
                for (int m = 0; m < 4; ++m) rrow[ai][m] = rs[row0 + ai * HALF + m * 16];
            asm volatile("" : "+v"(rrow[0][0]), "+v"(rrow[0][1]), "+v"(rrow[0][2]), "+v"(rrow[0][3]), "+v"(rrow[1][0]), "+v"(rrow[1][1]), "+v"(rrow[1][2]), "+v"(rrow[1][3])); }
#pragma unroll
        for (int ai = 0; ai < 2; ++ai)
#pragma unroll
            for (int m = 0; m < 4; ++m) {
                const float sg = rrow[ai][m] * isc, su = rrow[ai][m] * isc_u, ea = -1.4426950408889634f * sg, c = sg * su * (F8OUT ? osc : 1.f);
                const f32x4 g0 = cvacc<I8>(acc[ai][0][m][0]), g1 = cvacc<I8>(acc[ai][0][m][1]), u0 = cvacc<I8>(acc[ai][1][m][0]), u1 = cvacc<I8>(acc[ai][1][m][1]);
                const f32x2 h0 = sw2((f32x2){g0[0], g0[1]}, (f32x2){u0[0], u0[1]}, ea, c), h1 = sw2((f32x2){g0[2], g0[3]}, (f32x2){u0[2], u0[3]}, ea, c),
                            h2 = sw2((f32x2){g1[0], g1[1]}, (f32x2){u1[0], u1[1]}, ea, c), h3 = sw2((f32x2){g1[2], g1[3]}, (f32x2){u1[2], u1[3]}, ea, c);
                if constexpr (F8OUT) { unsigned char* rowp = OBLK ? (unsigned char*)O + (size_t)u.pm * BM * ldc + (size_t)(u.pn * 4 + wc) * 8192 + (wr * 64 + fr + ai * HALF + m * 16) * 32 + 8 * fq
                                                                  : (unsigned char*)O + (size_t)(row0 + ai * HALF + m * 16) * ldc + col0;
                    u32x2 w; w.x = pk4_fp8(h0.x, h0.y, h1.x, h1.y); w.y = pk4_fp8(h2.x, h2.y, h3.x, h3.y); *(u32x2*)rowp = w; }
                else { bf16_t* rowp = (bf16_t*)O + (size_t)(row0 + ai * HALF + m * 16) * ldc + col0;
                    u32x4 w; w.x = cvt_pk_bf16(h0.x, h0.y); w.y = cvt_pk_bf16(h1.x, h1.y); w.z = cvt_pk_bf16(h2.x, h2.y); w.w = cvt_pk_bf16(h3.x, h3.y); *(u32x4*)rowp = w; } }
    }
};
template <bool I8> struct EpiConvIn {
    static constexpr bool PERM = true; static constexpr int NST = 8;
    bf16_t* U; bf16_t* BG; const float* rs; float isc; mutable int cpm = -1; mutable float rrow[2][4];
    __device__ __forceinline__ void operator()(const f32x4 (&acc)[2][2][4][2], const Unit& u, int wr, int wc, int fr, int fq) const {
        const int row0 = u.pm * BM + wr * 64 + fr;
        if (I8 && u.pm != cpm) { cpm = u.pm;
#pragma unroll
            for (int ai = 0; ai < 2; ++ai)
#pragma unroll
                for (int m = 0; m < 4; ++m) rrow[ai][m] = rs[row0 + ai * HALF + m * 16];
            asm volatile("" : "+v"(rrow[0][0]), "+v"(rrow[0][1]), "+v"(rrow[0][2]), "+v"(rrow[0][3]), "+v"(rrow[1][0]), "+v"(rrow[1][1]), "+v"(rrow[1][2]), "+v"(rrow[1][3])); }
        if (u.pn < 16) {
            const int col0 = u.pn * HALF + wc * 32 + 8 * fq;
#pragma unroll
            for (int ai = 0; ai < 2; ++ai)
#pragma unroll
                for (int m = 0; m < 4; ++m) { bf16_t* rowp = U + (size_t)(row0 + ai * HALF + m * 16) * DM + col0;
                    const float rsc = I8 ? rrow[ai][m] * isc : 1.f, rs2 = rsc * rsc;
                    const f32x4 a0 = cvacc<I8>(acc[ai][0][m][0]) * cvacc<I8>(acc[ai][1][m][0]) * rs2, a1 = cvacc<I8>(acc[ai][0][m][1]) * cvacc<I8>(acc[ai][1][m][1]) * rs2;
                    u32x4 w; w.x = cvt_pk_bf16(a0[0], a0[1]); w.y = cvt_pk_bf16(a0[2], a0[3]); w.z = cvt_pk_bf16(a1[0], a1[1]); w.w = cvt_pk_bf16(a1[2], a1[3]);
                    *(u32x4*)rowp = w; }
        } else {
            const int col0 = (u.pn - 16) * BM + wc * 32 + 8 * fq;
#pragma unroll
            for (int ai = 0; ai < 2; ++ai)
#pragma unroll
                for (int m = 0; m < 4; ++m) { bf16_t* rowp = BG + (size_t)(row0 + ai * HALF + m * 16) * DM + col0;
                    const float rsc = I8 ? rrow[ai][m] * isc : 1.f;
#pragma unroll
                    for (int bj = 0; bj < 2; ++bj) { const f32x4 v0 = cvacc<I8>(acc[ai][bj][m][0]) * rsc, v1 = cvacc<I8>(acc[ai][bj][m][1]) * rsc;
                        u32x4 w; w.x = cvt_pk_bf16(v0[0], v0[1]); w.y = cvt_pk_bf16(v0[2], v0[3]); w.z = cvt_pk_bf16(v1[0], v1[1]); w.w = cvt_pk_bf16(v1[2], v1[3]);
                        *(u32x4*)(rowp + bj * HALF) = w; } }
        }
    }
};
template <bool I8 = false> struct EpiBf16T {
    static constexpr bool PERM = true; static constexpr int NST = 16;
    bf16_t* O; int ldc; float sc; const float* rs; mutable int cpm = -1; mutable float rrow[2][4];
    __device__ __forceinline__ void operator()(const f32x4 (&acc)[2][2][4][2], const Unit& u, int wr, int wc, int fr, int fq) const {
        const int row0 = u.pm * BM + wr * 64 + fr, col0 = u.pn * BM + wc * 32 + 8 * fq;
        if (I8 && u.pm != cpm) { cpm = u.pm;
#pragma unroll
            for (int ai = 0; ai < 2; ++ai)
#pragma unroll
                for (int m = 0; m < 4; ++m) rrow[ai][m] = rs[row0 + ai * HALF + m * 16];
            asm volatile("" : "+v"(rrow[0][0]), "+v"(rrow[0][1]), "+v"(rrow[0][2]), "+v"(rrow[0][3]), "+v"(rrow[1][0]), "+v"(rrow[1][1]), "+v"(rrow[1][2]), "+v"(rrow[1][3])); }
#pragma unroll
        for (int ai = 0; ai < 2; ++ai)
#pragma unroll
            for (int m = 0; m < 4; ++m) { bf16_t* rowp = O + (size_t)(row0 + ai * HALF + m * 16) * ldc + col0;
                const float rsc = I8 ? rrow[ai][m] * sc : sc;
#pragma unroll
                for (int bj = 0; bj < 2; ++bj) { const f32x4 v0 = cvacc<I8>(acc[ai][bj][m][0]) * rsc, v1 = cvacc<I8>(acc[ai][bj][m][1]) * rsc;
                    u32x4 w; w.x = cvt_pk_bf16(v0[0], v0[1]); w.y = cvt_pk_bf16(v0[2], v0[3]); w.z = cvt_pk_bf16(v1[0], v1[1]); w.w = cvt_pk_bf16(v1[2], v1[3]);
                    *(u32x4*)(rowp + bj * HALF) = w; } }
    }
};
typedef EpiBf16T<false> EpiBf16;
template <bool I8> struct EpiQKV {
    static constexpr bool PERM = true; static constexpr int NST = 16;
    bf16_t* O; float sc; const float* rs; const float* qg; const float* kg; const float* rope; float* kmean; LAS float* ex;
    mutable int cpm = -1; mutable float rrow[2][4];
    __device__ __forceinline__ void operator()(const f32x4 (&acc)[2][2][4][2], const Unit& u, int wr, int wc, int fr_, int fq_) const {
        int fr = fr_, fq = fq_; asm volatile("" : "+v"(fr), "+v"(fq));
        const int row0 = u.pm * BM + wr * 64 + fr;
        if (I8 && u.pm != cpm) { cpm = u.pm;
#pragma unroll
            for (int ai = 0; ai < 2; ++ai)
#pragma unroll
                for (int m = 0; m < 4; ++m) rrow[ai][m] = rs[row0 + ai * HALF + m * 16];
            asm volatile("" : "+v"(rrow[0][0]), "+v"(rrow[0][1]), "+v"(rrow[0][2]), "+v"(rrow[0][3]), "+v"(rrow[1][0]), "+v"(rrow[1][1]), "+v"(rrow[1][2]), "+v"(rrow[1][3])); }
        if (u.pn >= 16) {
            const int col0 = u.pn * BM + wc * 32 + 8 * fq;
#pragma unroll
            for (int ai = 0; ai < 2; ++ai)
#pragma unroll
                for (int m = 0; m < 4; ++m) { bf16_t* rowp = O + (size_t)(row0 + ai * HALF + m * 16) * 6144 + col0; const float rsc = I8 ? rrow[ai][m] * sc : sc;
#pragma unroll
                    for (int bj = 0; bj < 2; ++bj) { const f32x4 v0 = cvacc<I8>(acc[ai][bj][m][0]) * rsc, v1 = cvacc<I8>(acc[ai][bj][m][1]) * rsc;
                        u32x4 w; w.x = cvt_pk_bf16(v0[0], v0[1]); w.y = cvt_pk_bf16(v0[2], v0[3]); w.z = cvt_pk_bf16(v1[0], v1[1]); w.w = cvt_pk_bf16(v1[2], v1[3]);
                        *(u32x4*)(rowp + bj * HALF) = w; } }
            return;
        }
        const bool isk = u.pn >= 8; const int lane = threadIdx.x & 63;
        const int f0 = 16 * wc + 4 * fq;
        LAS float* P = ex; LAS float* KS = ex + 2048;
#pragma unroll
        for (int ai = 0; ai < 2; ++ai)
#pragma unroll
            for (int m = 0; m < 4; ++m) { const float rsc = I8 ? rrow[ai][m] * sc : sc; const int rl = wr * 64 + fr + ai * HALF + m * 16;
#pragma unroll
                for (int bj = 0; bj < 2; ++bj) { const f32x4 a = cvacc<I8>(acc[ai][bj][m][0]) * rsc, b = cvacc<I8>(acc[ai][bj][m][1]) * rsc;
                    float ss = (a[0] * a[0] + a[1] * a[1]) + (a[2] * a[2] + a[3] * a[3]) + (b[0] * b[0] + b[1] * b[1]) + (b[2] * b[2] + b[3] * b[3]);
                    ss += __shfl_xor(ss, 16); ss += __shfl_xor(ss, 32);
                    if (fq == 0) P[(rl * 2 + bj) * 4 + wc] = ss; } }
        asm volatile("s_waitcnt lgkmcnt(0)" ::: "memory"); __builtin_amdgcn_s_barrier(); asm volatile("" ::: "memory");
        const float* gn = isk ? kg : qg; const f32x4 g0 = *(const f32x4*)(gn + f0), g1 = *(const f32x4*)(gn + 64 + f0);
        f32x4 ks[2][2];
#pragma unroll
        for (int bj = 0; bj < 2; ++bj) { ks[bj][0] = (f32x4){0.f, 0.f, 0.f, 0.f}; ks[bj][1] = (f32x4){0.f, 0.f, 0.f, 0.f}; }
        const int colh = (isk ? DM : 0) + (u.pn & 7) * BM;
#pragma unroll
        for (int ai = 0; ai < 2; ++ai)
#pragma unroll
            for (int m = 0; m < 4; ++m) { const float rsc = I8 ? rrow[ai][m] * sc : sc; const int rl = wr * 64 + fr + ai * HALF + m * 16, row = u.pm * BM + rl, pos = row & (SEQ - 1);
                const f32x4 cs = *(const f32x4*)(rope + pos * 64 + f0), sn = *(const f32x4*)(rope + SEQ * 64 + pos * 64 + f0);
#pragma unroll
                for (int bj = 0; bj < 2; ++bj) { const LAS f32x4* pp = (const LAS f32x4*)(P + (rl * 2 + bj) * 4); const f32x4 p4 = *pp;
                    const float rstd = 1.0f / sqrtf(((p4[0] + p4[1]) + (p4[2] + p4[3])) * (1.f / HD) + NORM_EPS);
                    f32x4 t0 = acc[ai][bj][m][0], t1 = acc[ai][bj][m][1]; asm volatile("" : "+v"(t0), "+v"(t1));
                    const f32x4 y0 = cvacc<I8>(t0) * (rsc * rstd) * g0, y1 = cvacc<I8>(t1) * (rsc * rstd) * g1;
                    const f32x4 o0 = y0 * cs - y1 * sn, o1 = y1 * cs + y0 * sn;
                    ks[bj][0] += o0; ks[bj][1] += o1;
                    asm volatile("" : "+v"(ks[bj][0]), "+v"(ks[bj][1]));
                    bf16_t* rowp = O + (size_t)row * 6144 + colh + bj * HD + f0;
                    u32x2 w0; w0.x = cvt_pk_bf16(o0[0], o0[1]); w0.y = cvt_pk_bf16(o0[2], o0[3]); u32x2 w1; w1.x = cvt_pk_bf16(o1[0], o1[1]); w1.y = cvt_pk_bf16(o1[2], o1[3]);
                    *(u32x2*)rowp = w0; *(u32x2*)(rowp + 64) = w1; }
                asm volatile("" ::: "memory"); }
        if (isk) {
#pragma unroll
            for (int bj = 0; bj < 2; ++bj)
#pragma unroll
                for (int n = 0; n < 2; ++n)
#pragma unroll
                    for (int i = 0; i < 4; ++i) { float v = ks[bj][n][i]; v += __shfl_xor(v, 1); v += __shfl_xor(v, 2); v += __shfl_xor(v, 4); v += __shfl_xor(v, 8);
                        if (fr == 0) KS[(wr * 2 + bj) * HD + 64 * n + f0 + i] = v; }
            asm volatile("s_waitcnt lgkmcnt(0)" ::: "memory"); __builtin_amdgcn_s_barrier(); asm volatile("" ::: "memory");
            int t = threadIdx.x; asm volatile("" : "+v"(t)); if (t < 2 * HD) { const int bj = t >> 7, d = t & 127; const float v = KS[(0 * 2 + bj) * HD + d] + KS[(1 * 2 + bj) * HD + d];
                const int b = u.pm >> 3, blk = u.pm & 7, hh = 2 * (u.pn & 7) + bj; kmean[(((size_t)b * NH + hh) * NBLK + blk) * HD + d] = v * (1.f / MBLK); }
        }
        (void)lane;
    }
};

struct EpiSlab {
    static constexpr bool PERM = true; static constexpr int NST = 32;
    float* slabs;
    __device__ __forceinline__ void operator()(const f32x4 (&acc)[2][2][4][2], const Unit& u, int wr, int wc, int fr, int fq) const {
        float* sl = slabs + (size_t)u.slab * 65536; const int r0 = wr * 64 + fr, c0 = wc * 32 + 8 * fq;
#pragma unroll
        for (int ai = 0; ai < 2; ++ai)
#pragma unroll
            for (int m = 0; m < 4; ++m) { float* rowp = sl + (size_t)(r0 + ai * HALF + m * 16) * 256 + c0;
#pragma unroll
                for (int bj = 0; bj < 2; ++bj) { *(f32x4*)(rowp + bj * HALF) = acc[ai][bj][m][0]; *(f32x4*)(rowp + bj * HALF + 4) = acc[ai][bj][m][1]; } }
    }
};
typedef int i32x8 __attribute__((ext_vector_type(8)));
template <class Epi, class Sched, bool ALIGN_EPI, int MODE = 0, bool ABLK = false>
__device__ __forceinline__ void gemm_phase(LAS unsigned char* lds, const Gemm g, const Sched& S, const Epi& E) {
    constexpr bool F8 = MODE == 1, I8 = MODE == 2;
    const int tid = threadIdx.x, wid = __builtin_amdgcn_readfirstlane(tid >> 6), lane = tid & 63, wr = wid >> 2, wc = wid & 3, fr = lane & 15, fq = lane >> 4;
    const int rowB = g.rowB;
    unsigned voffA[2], voffB[2];
#pragma unroll
    for (int i = 0; i < 2; ++i) { int R, Cb; if constexpr (F8) stage_rc8(tid * 16 + i * 8192, R, Cb); else { stage_rc(tid * 16 + i * 8192, R, Cb); Cb *= 2; } const int Rb = Epi::PERM ? ((R & ~31) + perm32(R & 31)) : R;
        voffA[i] = ABLK ? (unsigned)((Cb >> 5) * 8192 + R * 32 + (Cb & 31)) : (unsigned)(R * rowB + Cb); voffB[i] = (unsigned)((Cb >> 5) * 8192 + Rb * 32 + (Cb & 31)); }
    const size_t kstep = (size_t)128;
    const size_t hstep = (size_t)HALF * rowB;
    const size_t tstep = 2 * hstep;
    const size_t kstepA = ABLK ? (size_t)32768 : kstep, hstepA = ABLK ? (size_t)4096 : hstep, kstepB = 32768, hstepB = 4096;
#define PG8_K0A(u_) (ABLK ? (size_t)(u_).k0b * 256 : (size_t)(u_).k0b)
    const unsigned ldsw = (unsigned)wid * 1024u;
    const int aoff = F8 ? lds_byte8(wr * 64 + fr, fq * 32) : lds_byte(wr * 64 + fr, fq * 8), boff = F8 ? lds_byte8(wc * 32 + fr, fq * 32) : lds_byte(wc * 32 + fr, fq * 8);
    const int aoff1 = F8 ? lds_byte8(wr * 64 + fr, fq * 32 + 16) : aoff + 1024, boff1 = F8 ? lds_byte8(wc * 32 + fr, fq * 32 + 16) : boff + 1024;
#define PG8_SA(b, h) (((b) * 2 + (h)) * HTB)
#define PG8_SB(b, h) ((4 + (b) * 2 + (h)) * HTB)
#define PG8_STAGE(bufoff, gbase, voff) do { _Pragma("unroll") for (int _i = 0; _i < 2; ++_i) \
        __builtin_amdgcn_global_load_lds((const unsigned*)((const char*)(gbase) + (voff)[_i]), (LAS unsigned*)(lds + (bufoff) + ldsw + _i * 8192), 16, 0, 0); } while (0)
#define PG8_LDA(dst, b, h) do { _Pragma("unroll") for (int m = 0; m < 4; ++m) { const i32x4_ l_ = *(const LAS i32x4_*)(lds + PG8_SA(b, h) + aoff + m * 2048), h_ = *(const LAS i32x4_*)(lds + PG8_SA(b, h) + aoff1 + m * 2048); dst[m] = __builtin_shufflevector(l_, h_, 0, 1, 2, 3, 4, 5, 6, 7); } } while (0)
#define PG8_LDB(dst, b, h) do { _Pragma("unroll") for (int n = 0; n < 2; ++n) { const i32x4_ l_ = *(const LAS i32x4_*)(lds + PG8_SB(b, h) + boff + n * 2048), h_ = *(const LAS i32x4_*)(lds + PG8_SB(b, h) + boff1 + n * 2048); dst[n] = __builtin_shufflevector(l_, h_, 0, 1, 2, 3, 4, 5, 6, 7); } } while (0)
#define PG8_BFLO(x) __builtin_bit_cast(bf16x8, __builtin_shufflevector(x, x, 0, 1, 2, 3))
#define PG8_BFHI(x) __builtin_bit_cast(bf16x8, __builtin_shufflevector(x, x, 4, 5, 6, 7))
#define PG8_MMA(ai, bj, At, Bt) do { __builtin_amdgcn_s_setprio(1); _Pragma("unroll") for (int m = 0; m < 4; ++m) _Pragma("unroll") for (int n = 0; n < 2; ++n) { if constexpr (F8) \
        asm volatile("v_mfma_scale_f32_16x16x128_f8f6f4 %0, %1, %2, %0, %3, %3 op_sel_hi:[0,0,0]" : "+v"(acc[ai][bj][m][n]) : "v"(Bt[n]), "v"(At[m]), "v"(one_scale)); \
        else if constexpr (I8) { i32x4_ c_ = __builtin_bit_cast(i32x4_, acc[ai][bj][m][n]); c_ = __builtin_amdgcn_mfma_i32_16x16x64_i8(__builtin_shufflevector(Bt[n], Bt[n], 0, 1, 2, 3), __builtin_shufflevector(At[m], At[m], 0, 1, 2, 3), c_, 0, 0, 0); \
               c_ = __builtin_amdgcn_mfma_i32_16x16x64_i8(__builtin_shufflevector(Bt[n], Bt[n], 4, 5, 6, 7), __builtin_shufflevector(At[m], At[m], 4, 5, 6, 7), c_, 0, 0, 0); acc[ai][bj][m][n] = __builtin_bit_cast(f32x4, c_); } \
        else { acc[ai][bj][m][n] = __builtin_amdgcn_mfma_f32_16x16x32_bf16(PG8_BFLO(Bt[n]), PG8_BFLO(At[m]), acc[ai][bj][m][n], 0, 0, 0); \
               acc[ai][bj][m][n] = __builtin_amdgcn_mfma_f32_16x16x32_bf16(PG8_BFHI(Bt[n]), PG8_BFHI(At[m]), acc[ai][bj][m][n], 0, 0, 0); } } __builtin_amdgcn_s_setprio(0); } while (0)
#define PG8_WAIT_V(n) asm volatile("s_waitcnt vmcnt(" #n ")" ::: "memory")
#define PG8_WAIT_L(n) asm volatile("s_waitcnt lgkmcnt(" #n ")" ::: "memory")
#define PG8_BAR __builtin_amdgcn_s_barrier()
#define PG8_SCHED __builtin_amdgcn_sched_barrier(0)
    Unit cur, nxt; int ui = 0;
    if (!S.next(0, cur)) return;
    f32x4 acc[2][2][4][2];
#pragma unroll
    for (int a = 0; a < 2; ++a)
#pragma unroll
        for (int b = 0; b < 2; ++b)
#pragma unroll
            for (int m = 0; m < 4; ++m)
#pragma unroll
                for (int n = 0; n < 2; ++n) acc[a][b][m][n] = (f32x4){0.f, 0.f, 0.f, 0.f};
    const int one_scale = 0x7f7f7f7f;
    i32x8 At[4], B0[2], B1[2];
    const char* cA = (const char*)g.A + (size_t)cur.pm * tstep + PG8_K0A(cur); const char* cB = (const char*)g.Bt + (size_t)cur.e * g.estride + (size_t)cur.pn * tstep + (size_t)cur.k0b * 256;
    PG8_STAGE(PG8_SB(0, 0), cB, voffB); PG8_STAGE(PG8_SB(0, 1), cB + hstepB, voffB); PG8_STAGE(PG8_SA(0, 0), cA, voffA); PG8_STAGE(PG8_SA(0, 1), cA + hstepA, voffA);
    if (wr == 1) PG8_BAR;
    PG8_WAIT_V(2); PG8_BAR;
    PG8_STAGE(PG8_SB(1, 0), cB + kstepB, voffB); PG8_STAGE(PG8_SA(1, 0), cA + kstepA, voffA); PG8_STAGE(PG8_SB(1, 1), cB + hstepB + kstepB, voffB);
    PG8_WAIT_V(6); PG8_BAR;
    for (;;) {
        const bool has_next = S.next(ui + 1, nxt);
        const char* nA = has_next ? (const char*)g.A + (size_t)nxt.pm * tstep + PG8_K0A(nxt) : cA; const char* nB = has_next ? (const char*)g.Bt + (size_t)nxt.e * g.estride + (size_t)nxt.pn * tstep + (size_t)nxt.k0b * 256 : cB;
        const int ntu = cur.nt;
#define PG8_WAIT_VI(n) asm volatile("s_waitcnt vmcnt(%0)" :: "i"(n) : "memory")
#define PG8_KPAIR(t, WA) do { \
            const bool last = ((t) == ntu - 2); \
            const char* a1 = cA + (size_t)((t) + 1) * kstepA; \
            const char* a2 = last ? nA : cA + (size_t)((t) + 2) * kstepA; const char* b2 = last ? nB : cB + (size_t)((t) + 2) * kstepB; \
            const char* a3 = a2 + kstepA; const char* b3 = b2 + kstepB; \
            PG8_LDB(B0, 0, 0); PG8_LDB(B1, 0, 1); PG8_SCHED; PG8_LDA(At, 0, 0); PG8_STAGE(PG8_SA(1, 1), a1 + hstepA, voffA); \
            if (WA) PG8_WAIT_VI(8 + Epi::NST); else PG8_WAIT_V(8); PG8_WAIT_L(0); PG8_BAR; PG8_MMA(0, 0, At, B0); PG8_MMA(0, 1, At, B1); PG8_BAR; PG8_SCHED; \
            PG8_LDA(At, 0, 1); PG8_STAGE(PG8_SB(0, 0), b2, voffB); PG8_STAGE(PG8_SB(0, 1), b2 + hstepB, voffB); PG8_STAGE(PG8_SA(0, 0), a2, voffA); \
            if (WA) PG8_WAIT_VI(8 + Epi::NST); else PG8_WAIT_V(8); PG8_WAIT_L(0); PG8_BAR; PG8_MMA(1, 0, At, B0); PG8_MMA(1, 1, At, B1); PG8_BAR; PG8_SCHED; \
            PG8_LDB(B0, 1, 0); PG8_LDB(B1, 1, 1); PG8_SCHED; PG8_LDA(At, 1, 0); PG8_STAGE(PG8_SA(0, 1), a2 + hstepA, voffA); \
            PG8_WAIT_V(8); PG8_WAIT_L(0); PG8_BAR; PG8_MMA(0, 0, At, B0); PG8_MMA(0, 1, At, B1); PG8_BAR; PG8_SCHED; \
            PG8_LDA(At, 1, 1); PG8_STAGE(PG8_SB(1, 0), b3, voffB); PG8_STAGE(PG8_SB(1, 1), b3 + hstepB, voffB); PG8_STAGE(PG8_SA(1, 0), a3, voffA); \
            PG8_WAIT_V(8); PG8_WAIT_L(0); PG8_BAR; PG8_MMA(1, 0, At, B0); PG8_MMA(1, 1, At, B1); PG8_BAR; PG8_SCHED; } while (0)
        int trel = ui > 0 ? 0 : -2; asm volatile("" : "+s"(trel));
        for (int t = 0; t < ntu; t += 2) { const bool relaxed = (t == trel); PG8_KPAIR(t, relaxed); }
#undef PG8_KPAIR
#undef PG8_WAIT_VI
        if constexpr (F8) asm volatile("s_nop 15\n\ts_nop 15" ::: "memory");
        if constexpr (ALIGN_EPI) { if (wr == 0) PG8_BAR; }
        E(acc, cur, wr, wc, fr, fq);
        if (!has_next) break;
#pragma unroll
        for (int a = 0; a < 2; ++a)
#pragma unroll
            for (int b = 0; b < 2; ++b)
#pragma unroll
                for (int m = 0; m < 4; ++m)
#pragma unroll
                    for (int n = 0; n < 2; ++n) acc[a][b][m][n] = (f32x4){0.f, 0.f, 0.f, 0.f};
        cur = nxt; cA = nA; cB = nB; ++ui;
        if constexpr (ALIGN_EPI) { if (wr == 1) PG8_BAR; }
    }
    PG8_WAIT_V(0);
    if constexpr (!ALIGN_EPI) { if (wr == 0) PG8_BAR; }
    PG8_BAR;
#undef PG8_K0A
#undef PG8_SA
#undef PG8_SB
#undef PG8_STAGE
#undef PG8_LDA
#undef PG8_LDB
#undef PG8_MMA
#undef PG8_BFLO
#undef PG8_BFHI
#undef PG8_WAIT_V
#undef PG8_WAIT_L
#undef PG8_BAR
#undef PG8_SCHED
}
}

namespace moba {
constexpr int D = 128, NW = 8, QBLK = 32, KVBLK = 64, QB = NW * QBLK;
constexpr int LDQ = 6144, LDO = 2048;
constexpr float SCALE = 0.08838834764831845f, THR = 8.f;
constexpr int SHM_V = KVBLK * D * 2, SHM_K = KVBLK * D * 2;
constexpr int UNI_OFF = 2 * SHM_V + 2 * SHM_K + NW * 64 * 4;
constexpr int NQREG = 4;
constexpr int Q_OFF = UNI_OFF + 64;
constexpr int LDS_BYTES = Q_OFF + NW * 8192;
#define KSWZ(row, colB) ((row) * 256 + ((colB) ^ (((row) & 7) << 4)))
#define SBAR() __builtin_amdgcn_sched_barrier(0)
__device__ __forceinline__ int v_st(int k, int c) { const int kk = (k & ~0xC) | ((k & 4) << 1) | ((k & 8) >> 1); return ((kk >> 3) * 4 + (c >> 5)) * 512 + ((kk & 7) * 32 + (c & 31)) * 2; }
__device__ __forceinline__ int v_rd_base(int lane) { return ((lane & 3) << 3) | (((lane >> 2) & 3) << 6) | (((lane >> 4) & 1) << 5) | (((lane >> 5) & 1) << 8); }
constexpr int v_rd_off(int d0, int ks, int half) { return d0 * 512 + ks * 4096 + half * 2048; }
__device__ __forceinline__ int crow(int r, int hi) { return (r & 3) + 8 * (r >> 2) + 4 * hi; }
__device__ __forceinline__ bf16x8 load8(const bf16_t* p) { return *reinterpret_cast<const bf16x8*>(p); }
__device__ __forceinline__ void mask_causal(f32x16& p0, f32x16& p1, int dq) {
    const float NEG = -__builtin_inff();
#pragma unroll
    for (int r = 0; r < 16; ++r) { const int c = (r & 3) + 8 * (r >> 2); if (dq - c < 0) p0[r] = NEG; if (dq - c - 32 < 0) p1[r] = NEG; }
}
__device__ __forceinline__ void mask_all(f32x16& p0, f32x16& p1, bool keep) {
    const float NEG = -__builtin_inff();
#pragma unroll
    for (int r = 0; r < 16; ++r) { p0[r] = keep ? p0[r] : NEG; p1[r] = keep ? p1[r] : NEG; }
}
__device__ __forceinline__ void partialSM(f32x16& p0, f32x16& p1, float& m_reg, float& mn, float& alpha) {
    float pmax = p0[0]; for (int r = 1; r < 16; ++r) pmax = fmaxf(pmax, p0[r]); for (int r = 0; r < 16; ++r) pmax = fmaxf(pmax, p1[r]);
    { auto rr = __builtin_amdgcn_permlane32_swap(__float_as_uint(pmax), __float_as_uint(pmax), false, false);
      pmax = fmaxf(__uint_as_float(rr[0]), __uint_as_float(rr[1])); }
    constexpr float C2 = 1.4426950408889634f * SCALE;
    if (__builtin_expect(__all((pmax - m_reg) * SCALE <= THR), 1)) { mn = m_reg; alpha = 1.f; }
    else { mn = fmaxf(m_reg, pmax); alpha = __builtin_amdgcn_exp2f((m_reg - mn) * C2); m_reg = mn; }
    const float mnL = -mn * C2;
    for (int r = 0; r < 16; ++r) p0[r] = fmaf(p0[r], C2, mnL); for (int r = 0; r < 16; ++r) p1[r] = fmaf(p1[r], C2, mnL);
    for (int r = 0; r < 16; ++r) p0[r] = __builtin_amdgcn_exp2f(p0[r]);
}
__device__ __forceinline__ void finishSM(f32x16& p0, f32x16& p1, float alpha, float& l_reg, bf16x8& pa0, bf16x8& pa1, bf16x8& pa2, bf16x8& pa3) {
    for (int r = 0; r < 16; ++r) p1[r] = __builtin_amdgcn_exp2f(p1[r]);
    float ps = 0; for (int r = 0; r < 16; ++r) ps += p0[r]; for (int r = 0; r < 16; ++r) ps += p1[r];
    { auto rr = __builtin_amdgcn_permlane32_swap(__float_as_uint(ps), __float_as_uint(ps), false, false);
      ps = __uint_as_float(rr[0]) + __uint_as_float(rr[1]); }
    l_reg = l_reg * alpha + ps;
#define PK4(P, B_, OUT) do { unsigned a0 = cvt_pk_bf16(P[B_+0], P[B_+1]), a1 = cvt_pk_bf16(P[B_+2], P[B_+3]);                          \
        unsigned b0 = cvt_pk_bf16(P[B_+4], P[B_+5]), b1 = cvt_pk_bf16(P[B_+6], P[B_+7]);                                             \
        auto r0 = __builtin_amdgcn_permlane32_swap(a0, b0, false, false); auto r1 = __builtin_amdgcn_permlane32_swap(a1, b1, false, false); \
        u32x4 w = {r0[0], r1[0], r0[1], r1[1]}; OUT = *reinterpret_cast<bf16x8*>(&w); } while (0)
    PK4(p0, 0, pa0); PK4(p0, 8, pa1); PK4(p1, 0, pa2); PK4(p1, 8, pa3);
#undef PK4
}
template <int KB>
__device__ __forceinline__ void qkt(f32x16& p0, f32x16& p1, const LAS char* K_lds, int r32, int hi, const LAS char* qw, const bf16x8 (&qreg)[NQREG], bool act) {
    if (!act) { const float NEG = -__builtin_inff();
#pragma unroll
        for (int r = 0; r < 16; ++r) { p0[r] = NEG; p1[r] = NEG; } return; }
    p0 = f32x16{}; p1 = f32x16{};
    const LAS char* kb[4];
#pragma unroll
    for (int dd = 0; dd < 4; ++dd) kb[dd] = K_lds + KB * SHM_K + KSWZ(r32, (dd * 16 + hi * 8) * 2);
#pragma unroll
    for (int d0 = 0; d0 < 8; ++d0) { const LAS char* a = kb[d0 & 3] + (d0 >> 2) * 128;
        bf16x8 b0 = *(const LAS bf16x8*)(a);
        bf16x8 b1 = *(const LAS bf16x8*)(a + 32 * 256);
        const bf16x8 q = d0 < NQREG ? qreg[d0 < NQREG ? d0 : 0] : *(const LAS bf16x8*)(qw + d0 * 1024);
        p0 = __builtin_amdgcn_mfma_f32_32x32x16_bf16(b0, q, p0, 0, 0, 0);
        p1 = __builtin_amdgcn_mfma_f32_32x32x16_bf16(b1, q, p1, 0, 0, 0); }
}
template <int VB>
__device__ __forceinline__ void pv_tile(f32x16* o, int vb0, bf16x8 pa0, bf16x8 pa1, bf16x8 pa2, bf16x8 pa3, bool act) {
    if (!act) return;
#define TRRD(dst, off) asm volatile("ds_read_b64_tr_b16 %0, %1 offset:%2" : "=&v"(dst) : "v"(vb0), "i"(off) : "memory")
#define PV_D0(d0) do { s16x4 l0, l1, l2, l3, h0, h1, h2, h3; constexpr int b_ = VB * SHM_V + v_rd_off(d0, 0, 0); \
        TRRD(l0, b_); TRRD(h0, b_ + 2048); TRRD(l1, b_ + 4096); TRRD(h1, b_ + 6144); TRRD(l2, b_ + 8192); TRRD(h2, b_ + 10240); TRRD(l3, b_ + 12288); TRRD(h3, b_ + 14336); \
        asm volatile("s_waitcnt lgkmcnt(0)" ::: "memory"); SBAR();   \
        o[d0] = __builtin_amdgcn_mfma_f32_32x32x16_bf16(pa0, (bf16x8){l0[0], l0[1], l0[2], l0[3], h0[0], h0[1], h0[2], h0[3]}, o[d0], 0, 0, 0);   \
        o[d0] = __builtin_amdgcn_mfma_f32_32x32x16_bf16(pa1, (bf16x8){l1[0], l1[1], l1[2], l1[3], h1[0], h1[1], h1[2], h1[3]}, o[d0], 0, 0, 0);   \
        o[d0] = __builtin_amdgcn_mfma_f32_32x32x16_bf16(pa2, (bf16x8){l2[0], l2[1], l2[2], l2[3], h2[0], h2[1], h2[2], h2[3]}, o[d0], 0, 0, 0);   \
        o[d0] = __builtin_amdgcn_mfma_f32_32x32x16_bf16(pa3, (bf16x8){l3[0], l3[1], l3[2], l3[3], h3[0], h3[1], h3[2], h3[3]}, o[d0], 0, 0, 0); } while (0)
    PV_D0(0); PV_D0(1); PV_D0(2); PV_D0(3);
#undef PV_D0
#undef TRRD
}
struct BlockRef { const bf16_t* Q; const bf16_t* K; const bf16_t* V; unsigned char* O; int P0; const float* km; };
struct Seam { bf16x8 st_v0, st_v1, st_k0, st_k1; };
#define ROW(p, k0, rr) ((p) + (size_t)((k0) + (rr)) * LDQ + sc)
#define VMWN(n) asm volatile("s_waitcnt vmcnt(%0)" :: "i"(n) : "memory")
#define SLOAD_H(Kp, Vp, k0) do { S.st_v0 = load8(ROW(Vp, k0, sr)); S.st_v1 = load8(ROW(Vp, k0, 32 + sr));              \
                         S.st_k0 = load8(ROW(Kp, k0, sr)); S.st_k1 = load8(ROW(Kp, k0, 32 + sr)); } while (0)
#define QDMA(Qp) do { _Pragma("unroll") for (int d0 = 0; d0 < 8; ++d0) __builtin_amdgcn_global_load_lds((const unsigned*)((Qp) + (size_t)(wid * QBLK + r32) * LDQ + d0 * 16 + hi * 8), (LAS unsigned*)(lds + Q_OFF + wid * 8192 + d0 * 1024), 16, 0, 0); } while (0)
#define SWRITE_HK(bf) do { *(LAS bf16x8*)(K_lds + (bf) * SHM_K + kws) = S.st_k0; *(LAS bf16x8*)(K_lds + (bf) * SHM_K + kws + 32 * 256) = S.st_k1; } while (0)
#define SWRITE_HV(bf) do { *(LAS bf16x8*)(V_lds + (bf) * SHM_V + vst0) = S.st_v0; *(LAS bf16x8*)(V_lds + (bf) * SHM_V + vst1) = S.st_v1; } while (0)
#define SWRITE_H(bf) do { SWRITE_HV(bf); SWRITE_HK(bf); } while (0)
__device__ __forceinline__ void moba_prime(const BlockRef& cur, LAS char* lds, Seam& S) {
    const int tid = threadIdx.x, wid = __builtin_amdgcn_readfirstlane(tid >> 6), lane = tid & 63, r32 = lane & 31, hi = lane >> 5;
    const int sr = tid >> 4, sc = (tid & 15) * 8, kws = KSWZ(sr, sc * 2); LAS char* K_lds = lds + 2 * SHM_V;
    const int kb0 = cur.P0;
    QDMA(cur.Q);
    SLOAD_H(cur.K, cur.V, kb0); VM_WAIT(); SWRITE_HK(0);
    __syncthreads();
}
__device__ __forceinline__ void moba_block(const BlockRef& cur, const BlockRef& nxt, LAS char* lds, Seam& S) {
    const int tid = threadIdx.x, wid = __builtin_amdgcn_readfirstlane(tid >> 6), lane = tid & 63, r32 = lane & 31, hi = lane >> 5;
    const int own = cur.P0 >> 8;
    const int kbn = nxt.P0;
    const int qlo = cur.P0 + wid * QBLK, qm = qlo + r32 - 4 * hi;
    LAS char* V_lds = lds; LAS char* K_lds = lds + 2 * SHM_V;
    LAS float* ws = (LAS float*)(lds + 2 * SHM_V + 2 * SHM_K) + wid * 64; LAS float* li_l = ws; LAS float* al_l = ws + 32;
    LAS unsigned* uni = (LAS unsigned*)(lds + UNI_OFF);
    float m_reg = -1e30f, l_reg = 0; f32x16 o[4] = {};
    const int sr = tid >> 4, sc = (tid & 15) * 8, vst0 = v_st(sr, sc), vst1 = v_st(32 + sr, sc), kws = KSWZ(sr, sc * 2);
    const int vb0 = (int)(unsigned)(uintptr_t)V_lds + v_rd_base(lane);
    const bf16_t* Kh = cur.K; const bf16_t* Vh = cur.V;
    LAS char* qw = lds + Q_OFF + wid * 8192 + lane * 16;
    SWRITE_HV(0); SBAR();
    SLOAD_H(Kh, Vh, cur.P0 + KVBLK);
    VMWN(4); SBAR();
    bf16x8 qreg[NQREG];
#pragma unroll
    for (int d0 = 0; d0 < NQREG; ++d0) qreg[d0] = *(const LAS bf16x8*)(qw + d0 * 1024);
    unsigned selbits = 0u;
    if (own > 0) {
        if (own <= TOPK) selbits = (1u << own) - 1u;
        else {
            float g[7];
#pragma unroll
            for (int j = 0; j < 7; ++j) { g[j] = -__builtin_inff();
                if (j < own) { float a = 0.f; const float* kmj = cur.km + j * D + hi * 8;
#pragma unroll
                    for (int d0 = 0; d0 < 8; ++d0) { const f32x4 k0 = *(const f32x4*)(kmj + d0 * 16), k1 = *(const f32x4*)(kmj + d0 * 16 + 4); const u32x4 qv = *(const LAS u32x4*)(qw + d0 * 1024);
                        a = fmaf(bf_lo(qv.x), k0[0], a); a = fmaf(bf_hi(qv.x), k0[1], a); a = fmaf(bf_lo(qv.y), k0[2], a); a = fmaf(bf_hi(qv.y), k0[3], a);
                        a = fmaf(bf_lo(qv.z), k1[0], a); a = fmaf(bf_hi(qv.z), k1[1], a); a = fmaf(bf_lo(qv.w), k1[2], a); a = fmaf(bf_hi(qv.w), k1[3], a); }
                    auto rr = __builtin_amdgcn_permlane32_swap(__float_as_uint(a), __float_as_uint(a), false, false);
                    g[j] = __uint_as_float(rr[0]) + __uint_as_float(rr[1]); } }
#pragma unroll
            for (int k = 0; k < TOPK; ++k) { float best = -__builtin_inff(); int bi = 0;
#pragma unroll
                for (int j = 6; j >= 0; --j) { const bool ok = (j < own) && !((selbits >> j) & 1u) && (g[j] >= best); best = ok ? g[j] : best; bi = ok ? j : bi; }
                selbits |= 1u << bi; }
        }
    }
    unsigned wuni = 0u;
#pragma unroll
    for (int j = 0; j < 7; ++j) wuni |= (__ballot((selbits >> j) & 1u) != 0ull) ? (1u << j) : 0u;
    if (lane == 0) uni[wid] = wuni;
#define RESC(a) do { if (__any((a) < 1.f)) { if (hi == 0) al_l[r32] = (a); asm volatile("s_waitcnt lgkmcnt(0)" ::: "memory");              \
                     for (int d_ = 0; d_ < 4; ++d_) for (int r = 0; r < 16; ++r) o[d_][r] *= al_l[crow(r, hi)]; } } while (0)
    unsigned blist = (unsigned)own; int NT = 4;
#define BLK(t) ((int)((blist >> (4 * ((t) >> 2))) & 15u))
#define KBASE(t) (BLK(t) * MBLK + ((t) & 3) * KVBLK)
#define ACT(t) (BLK(t) == own ? (KBASE(t) <= qlo + QBLK - 1) : (((wuni >> BLK(t)) & 1u) != 0u))
#define MASKT(P0_, P1_, t) do { const int kb_ = KBASE(t); if (ACT(t)) { if (BLK(t) == own) { if (kb_ + KVBLK - 1 > qlo) mask_causal(P0_, P1_, qm - kb_); } \
                                                                          else mask_all(P0_, P1_, ((selbits >> BLK(t)) & 1u) != 0u); } } while (0)
    constexpr int NQL = 8;
#define SEAM_K0() do { VMWN(NQL); SWRITE_HK(0); SBAR(); } while (0)
    f32x16 pA0, pA1, pB0, pB1; float mnA, mnB, alA, alB; bf16x8 pa0, pa1, pa2, pa3;
    SBAR(); qkt<0>(pA0, pA1, K_lds, r32, hi, qw, qreg, ACT(0));
    MASKT(pA0, pA1, 0); partialSM(pA0, pA1, m_reg, mnA, alA);
    VM_WAIT(); SWRITE_H(1);
    __syncthreads();
    {
        unsigned bu = 0u;
#pragma unroll
        for (int w = 0; w < NW; ++w) bu |= uni[w];
        bu = (unsigned)__builtin_amdgcn_readfirstlane((int)bu);
        int ne = 1;
        for (int j = 0; j < 7; ++j) if ((bu >> j) & 1u) { blist |= (unsigned)j << (4 * ne); ++ne; }
        NT = 4 * ne;
    }
#define HALF_STEP(PX0, PX1, mnX, alX, PY0, PY1, alY, t, KB, VB, SB) do {                                                      \
        SBAR(); qkt<KB>(PX0, PX1, K_lds, r32, hi, qw, qreg, ACT(t));                                             \
        finishSM(PY0, PY1, alY, l_reg, pa0, pa1, pa2, pa3); SBAR();                                                           \
        if ((t) + 1 < NT) { SLOAD_H(Kh, Vh, KBASE((t) + 1)); SBAR(); }                                               \
        pv_tile<VB>(o, vb0, pa0, pa1, pa2, pa3, ACT((t) - 1)); MASKT(PX0, PX1, (t)); partialSM(PX0, PX1, m_reg, mnX, alX);                                        \
        __syncthreads();                                                                                                      \
        if ((t) + 1 < NT) { VM_WAIT(); SWRITE_H(SB); }                                                                          \
        RESC(alX); __syncthreads(); } while (0)
    for (int t = 1; t + 1 < NT; t += 2) {
        HALF_STEP(pB0, pB1, mnB, alB, pA0, pA1, alA, t, 1, 0, 0);
        HALF_STEP(pA0, pA1, mnA, alA, pB0, pB1, alB, t + 1, 0, 1, 1);
    }
    SBAR(); qkt<1>(pB0, pB1, K_lds, r32, hi, qw, qreg, ACT(NT - 1)); SBAR();
    SLOAD_H(nxt.K, nxt.V, kbn); SBAR();
    QDMA(nxt.Q);
    SBAR();
    finishSM(pA0, pA1, alA, l_reg, pa0, pa1, pa2, pa3); SBAR();
    pv_tile<0>(o, vb0, pa0, pa1, pa2, pa3, ACT(NT - 2));
    MASKT(pB0, pB1, NT - 1); partialSM(pB0, pB1, m_reg, mnB, alB); __syncthreads(); RESC(alB);
    finishSM(pB0, pB1, alB, l_reg, pa0, pa1, pa2, pa3); SBAR(); pv_tile<1>(o, vb0, pa0, pa1, pa2, pa3, ACT(NT - 1));
    SBAR(); SEAM_K0();
    if (hi == 0) li_l[r32] = l_reg; asm volatile("s_waitcnt lgkmcnt(0)" ::: "memory");
    float rli[16];
#pragma unroll
    for (int r = 0; r < 16; ++r) rli[r] = __builtin_amdgcn_rcpf(li_l[crow(r, hi)]);
    constexpr int OES = F8_AOUT ? 1 : 2;
    unsigned char* Ow = cur.O + (size_t)(wid * QBLK) * LDO * OES;
#pragma unroll
    for (int r = 0; r < 16; ++r) { const int orow = crow(r, hi);
#pragma unroll
        for (int d0 = 0; d0 < 4; ++d0) { const float v = o[d0][r] * rli[r];
            if constexpr (F8_AOUT) {
                const int vi = __builtin_bit_cast(int, v * O_SCALE);
                const float v1 = __builtin_bit_cast(float, __builtin_amdgcn_mov_dpp(vi, 0x55, 0xF, 0xF, true)), v2 = __builtin_bit_cast(float, __builtin_amdgcn_mov_dpp(vi, 0xAA, 0xF, 0xF, true)), v3 = __builtin_bit_cast(float, __builtin_amdgcn_mov_dpp(vi, 0xFF, 0xF, 0xF, true));
                if ((r32 & 3) == 0) *(unsigned*)(Ow + (size_t)orow * LDO + d0 * 32 + r32) = pk4_fp8(v * O_SCALE, v1, v2, v3);
            } else {
            const float vn = __builtin_bit_cast(float, __builtin_amdgcn_mov_dpp(__builtin_bit_cast(int, v), 0xB1, 0xF, 0xF, true));
            if ((r32 & 1) == 0) *(unsigned*)(Ow + ((size_t)orow * LDO + d0 * 32 + r32) * 2) = cvt_pk_bf16(v, vn); } } }
    __syncthreads();
#undef RESC
#undef BLK
#undef KBASE
#undef ACT
#undef MASKT
#undef SEAM_K0
#undef HALF_STEP
}
#undef ROW
#undef VMWN
#undef SLOAD_H
#undef SWRITE_HK
#undef QDMA
#undef SWRITE_HV
#undef SWRITE_H
#undef SBAR
#undef KSWZ
}
static_assert(moba::LDS_BYTES <= PHASE_LDS, "attention LDS");

#define XB_TMO      128
#define XB_XCNT(j)  (256  + 64 * (j))
#define XB_XSUB(j)  (1280 + 64 * (j))
#define XB_XGEN(j)  (2304 + 64 * (j))
#define XB_TOP      3328
#define XB_TOPGEN   3392
#define XCD_BAR_WORDS 3456
#define XB_SPIN_CAP (1u << 22)
__device__ __forceinline__ unsigned xb_ld(unsigned* p)              { return __hip_atomic_load(p, __ATOMIC_RELAXED, __HIP_MEMORY_SCOPE_AGENT); }
__device__ __forceinline__ unsigned xb_add(unsigned* p, unsigned v) { return __hip_atomic_fetch_add(p, v, __ATOMIC_RELAXED, __HIP_MEMORY_SCOPE_AGENT); }
__device__ __forceinline__ unsigned xb_xcc_id() { return (unsigned)__builtin_amdgcn_s_getreg((3 << 11) | 20) & 0xFu; }
#define XB_SPIN(cond, bar) do { unsigned _sp = 0; while (cond) { __builtin_amdgcn_s_sleep(1); \
    if ((++_sp & 255u) == 0u) { if (xb_ld(&(bar)[XB_TMO])) break; if (_sp > XB_SPIN_CAP) { atomicAdd(&(bar)[XB_TMO], 1u); break; } } } } while (0)
struct XcdBarrier { unsigned* bar; unsigned x; volatile LAS unsigned* st; };
__device__ __forceinline__ XcdBarrier xcd_barrier_post(unsigned* bar, volatile LAS unsigned* st) {
    XcdBarrier b; b.bar = bar; b.x = xb_xcc_id(); b.st = st;
    if (threadIdx.x == 0) (void)xb_add(&bar[XB_XCNT(b.x)], 1u);
    return b;
}
__device__ __forceinline__ void xcd_barrier_complete(unsigned* bar, unsigned x, unsigned& nloc, unsigned& nx) {
    const unsigned G = gridDim.x * gridDim.y * gridDim.z;
    unsigned sum, cnt, mine, sp = 0u;
    for (;;) {
        sum = 0u; cnt = 0u; mine = 0u;
#pragma unroll
        for (unsigned j = 0; j < 16; ++j) { const unsigned c = xb_ld(&bar[XB_XCNT(j)]); sum += c; cnt += (c > 0u) ? 1u : 0u; mine = (j == x) ? c : mine; }
        if (sum == G) break;
        __builtin_amdgcn_s_sleep(1);
        if ((++sp & 255u) == 0u) { if (xb_ld(&bar[XB_TMO])) break; if (sp > XB_SPIN_CAP) { atomicAdd(&bar[XB_TMO], 1u); break; } }
    }
    nloc = mine > 0u ? mine : 1u; nx = cnt > 0u ? cnt : 1u;
}
__device__ __forceinline__ void xcd_barrier(const XcdBarrier& b) {
    asm volatile("s_waitcnt vmcnt(0)" ::: "memory");
    __syncthreads();
    if (threadIdx.x == 0) {
        unsigned* bar = b.bar;
        __builtin_amdgcn_s_waitcnt(0);
        unsigned nloc = b.st[0], nx = b.st[1];
        if (nloc == 0u) { xcd_barrier_complete(bar, b.x, nloc, nx); b.st[0] = nloc; b.st[1] = nx; }
        const unsigned old = xb_add(&bar[XB_XSUB(b.x)], 1u);
        const unsigned gen = old / nloc;
        if (old + 1u == (gen + 1u) * nloc) {
            __builtin_amdgcn_fence(__ATOMIC_RELEASE, "agent");
            asm volatile("s_waitcnt vmcnt(0)" ::: "memory");
            const unsigned og = xb_add(&bar[XB_TOP], 1u);
            const unsigned tg = og / nx;
            if (og + 1u == (tg + 1u) * nx) xb_add(&bar[XB_TOPGEN], 1u);
            else XB_SPIN(xb_ld(&bar[XB_TOPGEN]) == tg, bar);
            __builtin_amdgcn_fence(__ATOMIC_ACQUIRE, "agent");
            xb_add(&bar[XB_XGEN(b.x)], 1u);
            asm volatile("s_waitcnt vmcnt(0)" ::: "memory");
        } else {
            XB_SPIN(xb_ld(&bar[XB_XGEN(b.x)]) == gen, bar);
            __builtin_amdgcn_fence(__ATOMIC_ACQUIRE, "agent");
            asm volatile("s_waitcnt vmcnt(0)" ::: "memory");
        }
    }
    __syncthreads();
}

constexpr int NWAVES = 8;
struct Frame {
    LAS unsigned char* lds; char* ldsg;
    int tid, lane, wave, vcu, G;
    unsigned char* ws;
};
enum { IN_X = 0, IN_C, IN_MODW, IN_MODB, IN_NMIX, IN_NFFN, IN_CONVIN, IN_CONVW, IN_CONVOUT, IN_FGATE, IN_FUP, IN_FDOWN, IN_QKVW, IN_QNORM, IN_KNORM, IN_AOUT, IN_RW, IN_RB, IN_EGATE, IN_EUP, IN_EDOWN, N_IN };
struct Args { const float* in[N_IN]; float* out; unsigned char* ws; int ph_lo, ph_hi, use_bar, pad; };

__device__ __forceinline__ void mod_phase(Frame& F, const float* c, const float* modw, const float* modb, float* mod) {
    LAS float* cact = (LAS float*)F.lds;
    LAS float* red = (LAS float*)(F.lds + 65536);
    constexpr int NU = 2 * (6 * DM / 128);
    if ((int)blockIdx.x >= NU) return;
    for (int i = F.tid; i < NB * DM; i += NWAVES * 64) { const int b = i / DM, d = i % DM; const float v = c[i]; cact[d * 8 + b] = v / (1.0f + __expf(-v)); }
    __syncthreads();
    for (int u = blockIdx.x; u < NU; u += F.G) {
        const int layer = u / (6 * DM / 128), col0 = (u % (6 * DM / 128)) * 128;
        const int cg = F.tid & 31, rg = F.tid >> 5;
        const float* W = modw + (size_t)layer * DM * (6 * DM) + col0 + 4 * cg;
        f32x4 acc[8];
#pragma unroll
        for (int b = 0; b < 8; ++b) acc[b] = (f32x4){0.f, 0.f, 0.f, 0.f};
#pragma unroll 8
        for (int it = 0; it < DM / 16; ++it) { const int r = rg + 16 * it; const f32x4 w = *(const f32x4*)(W + (size_t)r * (6 * DM));
            const f32x4 c0 = *(const LAS f32x4*)(cact + r * 8), c1 = *(const LAS f32x4*)(cact + r * 8 + 4);
            acc[0] += w * c0[0]; acc[1] += w * c0[1]; acc[2] += w * c0[2]; acc[3] += w * c0[3]; acc[4] += w * c1[0]; acc[5] += w * c1[1]; acc[6] += w * c1[2]; acc[7] += w * c1[3]; }
#pragma unroll
        for (int b = 0; b < 8; ++b) *(LAS f32x4*)(red + rg * 1024 + cg * 32 + b * 4) = acc[b];
        __syncthreads();
        for (int o = F.tid; o < 1024; o += NWAVES * 64) { float s = 0.f;
#pragma unroll
            for (int r = 0; r < 16; ++r) s += red[r * 1024 + o];
            const int cgo = o >> 5, b = (o >> 2) & 7, i = o & 3, col = col0 + 4 * cgo + i;
            mod[((size_t)layer * NB + b) * (6 * DM) + col] = s + modb[layer * (6 * DM) + col]; }
        __syncthreads();
    }
}
__device__ __forceinline__ void rope_table_phase(Frame& F, float* tab) {
    const int gt = blockIdx.x * (NWAVES * 64) + F.tid, NT = F.G * NWAVES * 64;
    for (int i = gt; i < SEQ * 64; i += NT) { const int pos = i >> 6, f = i & 63; const float inv = expf(-9.210340371976184f * (float)f / 64.0f); const float ang = (float)pos * inv;
        float s, co; sincosf(ang, &s, &co); tab[i] = co; tab[SEQ * 64 + i] = s; }
}
__device__ __forceinline__ void cvt_item(const float* src, int ldsrc, int k0, int n0, bf16_t* dst, int Kd, int drow0, LAS float* scr, int lane) {
    float v[32];
#pragma unroll
    for (int i = 0; i < 32; ++i) { const int kk = 2 * i + (lane >> 5); v[i] = src[(size_t)(k0 + kk) * ldsrc + n0 + (lane & 31)]; }
#pragma unroll
    for (int i = 0; i < 32; ++i) { const int kk = 2 * i + (lane >> 5); scr[kk * 33 + (lane & 31)] = v[i]; }
    LDS_WAIT(); asm volatile("" ::: "memory");
    const int c = lane & 7;
#pragma unroll
    for (int j = 0; j < 4; ++j) { const int n = (lane >> 3) + 8 * j; const LAS float* s = scr + (8 * c) * 33 + n;
        u32x4 o; o.x = pk2(s[0 * 33], s[1 * 33]); o.y = pk2(s[2 * 33], s[3 * 33]); o.z = pk2(s[4 * 33], s[5 * 33]); o.w = pk2(s[6 * 33], s[7 * 33]);
        *(u32x4*)(dst + (size_t)(drow0 + n) * Kd + k0 + 8 * c) = o; }
    LDS_WAIT(); asm volatile("" ::: "memory");
}
__device__ __forceinline__ void cvt_item8(const float* src, int ldsrc, int k0, int n0, unsigned char* dst, int Kd, int drow0, LAS float* scr, int lane) {
    float v[32];
#pragma unroll
    for (int i = 0; i < 32; ++i) { const int kk = 2 * i + (lane >> 5); v[i] = src[(size_t)(k0 + kk) * ldsrc + n0 + (lane & 31)]; }
#pragma unroll
    for (int i = 0; i < 32; ++i) { const int kk = 2 * i + (lane >> 5); scr[kk * 33 + (lane & 31)] = v[i] * W_SCALE; }
    LDS_WAIT(); asm volatile("" ::: "memory");
    const int c = lane & 7;
#pragma unroll
    for (int j = 0; j < 4; ++j) { const int n = (lane >> 3) + 8 * j; const LAS float* s = scr + (8 * c) * 33 + n;
        u32x2 o; o.x = pk4_fp8(s[0 * 33], s[1 * 33], s[2 * 33], s[3 * 33]); o.y = pk4_fp8(s[4 * 33], s[5 * 33], s[6 * 33], s[7 * 33]);
        *(u32x2*)(dst + (size_t)(drow0 + n) * Kd + k0 + 8 * c) = o; }
    LDS_WAIT(); asm volatile("" ::: "memory");
}
__device__ __forceinline__ int pair_row(int n, int s) { return 256 * (n >> 7) + 128 * s + (n & 127); }
__device__ __forceinline__ void calib_phase(Frame& F, const Args& a, LAS float* wsc_l, float* wsc_g) {
    LAS float* red = (LAS float*)F.lds;
    for (int t = 0; t < WQ_N; ++t) {
        const float* p; size_t n;
        switch (t) { case WQ_CONVIN: p = a.in[IN_CONVIN]; n = (size_t)DM * 3 * DM; break; case WQ_FGATE: p = a.in[IN_FGATE]; n = (size_t)DM * FF; break; case WQ_FUP: p = a.in[IN_FUP]; n = (size_t)DM * FF; break;
                     case WQ_QKV: p = a.in[IN_QKVW]; n = (size_t)DM * 3 * DM; break; case WQ_EGATE: p = a.in[IN_EGATE]; n = (size_t)NE * DM * FFE; break; default: p = a.in[IN_EUP]; n = (size_t)NE * DM * FFE; break; }
        float ss = 0.f;
#pragma unroll
        for (int k = 0; k < 8; ++k) { const int i = F.tid + 512 * k, chunk = i >> 10, off = i & 1023; const f32x4 v = *(const f32x4*)(p + (n / 4) * chunk + 4 * off); ss += (v.x * v.x + v.y * v.y) + (v.z * v.z + v.w * v.w); }
        ss = wave_sum(ss); if (F.lane == 0) red[F.wave] = ss;
        __syncthreads();
        if (F.tid == 0) { float tot = 0.f; for (int w = 0; w < NWAVES; ++w) tot += red[w]; const float rms = sqrtf(tot * (1.f / 16384.f)); const float sc = 127.f / (WI8_CLIP * fmaxf(rms, 1e-30f)); wsc_l[t] = sc; if (blockIdx.x == 0) wsc_g[t] = sc; }
        __syncthreads();
    }
}
__host__ __device__ __forceinline__ int qk_slot(int d) { return 32 * ((d >> 4) & 3) + 8 * ((d >> 2) & 3) + 4 * (d >> 6) + (d & 3); }
struct CvtDesc { const float* src; int ld; unsigned char* dst; int kb0; int f8; float sc; int pd0; };
__device__ __forceinline__ CvtDesc cvt_decode(int it, const Args& a, unsigned char* ws, const LAS float* wsc) {
    constexpr int I0 = (DM / 64) * (3 * DM / 32), I1 = (DM / 64) * (DM / 32), I2 = (DM / 64) * (FF / 32), I4 = (FF / 64) * (DM / 32), IE = (DM / 64) * (FFE / 32), ID = (FFE / 64) * (DM / 32);
    const float* src; int ld, K, kb, n0, drow, f8, wq = 0, pd0 = -1; unsigned char* dbase; size_t eoff = 0; int r = it;
    if (r < I0) { const int nb = 3 * DM / 64; kb = r / nb; n0 = (r % nb) * 64; src = a.in[IN_CONVIN]; ld = 3 * DM; K = DM; f8 = MD_CONVIN; wq = WQ_CONVIN; dbase = ws + WS_W1;
        drow = n0 < DM ? 2 * DM + n0 : (n0 < 2 * DM ? pair_row(n0 - DM, 0) : pair_row(n0 - 2 * DM, 1)); }
    else if ((r -= I0) < I1) { const int nb = DM / 64; kb = r / nb; n0 = (r % nb) * 64; src = a.in[IN_CONVOUT]; ld = DM; K = DM; f8 = 0; dbase = ws + WS_W2; drow = n0; }
    else if ((r -= I1) < I2) { const int nb = FF / 64; kb = r / nb; n0 = (r % nb) * 64; src = a.in[IN_FGATE]; ld = FF; K = DM; f8 = MD_FFN_GU; wq = WQ_FGATE; dbase = ws + WS_W3; drow = pair_row(n0, 0); }
    else if ((r -= I2) < I2) { const int nb = FF / 64; kb = r / nb; n0 = (r % nb) * 64; src = a.in[IN_FUP]; ld = FF; K = DM; f8 = MD_FFN_GU; wq = WQ_FUP; dbase = ws + WS_W3; drow = pair_row(n0, 1); }
    else if ((r -= I2) < I4) { const int nb = DM / 64; kb = r / nb; n0 = (r % nb) * 64; src = a.in[IN_FDOWN]; ld = DM; K = FF; f8 = F8_FFN_DN; dbase = ws + WS_W4; drow = n0; }
    else if ((r -= I4) < I0) { const int nb = 3 * DM / 64; kb = r / nb; n0 = (r % nb) * 64; src = a.in[IN_QKVW]; ld = 3 * DM; K = DM; f8 = MD_QKV; wq = WQ_QKV; dbase = ws + WS_W5; drow = n0; if (QK_FUSED && n0 < 2 * DM) { pd0 = n0 & 127; drow = n0 & ~127; } }
    else if ((r -= I0) < I1) { const int nb = DM / 64; kb = r / nb; n0 = (r % nb) * 64; src = a.in[IN_AOUT]; ld = DM; K = DM; f8 = F8_AOUT; dbase = ws + WS_W6; drow = n0; }
    else if ((r -= I1) < NE * IE) { const int e = r / IE, q = r % IE, nb = FFE / 64; kb = q / nb; n0 = (q % nb) * 64; src = a.in[IN_EGATE] + (size_t)e * DM * FFE; ld = FFE; K = DM; f8 = MD_MOE_GU; wq = WQ_EGATE; dbase = ws + WS_W7; eoff = (size_t)e * 2 * FFE * DM; drow = pair_row(n0, 0); }
    else if ((r -= NE * IE) < NE * IE) { const int e = r / IE, q = r % IE, nb = FFE / 64; kb = q / nb; n0 = (q % nb) * 64; src = a.in[IN_EUP] + (size_t)e * DM * FFE; ld = FFE; K = DM; f8 = MD_MOE_GU; wq = WQ_EUP; dbase = ws + WS_W7; eoff = (size_t)e * 2 * FFE * DM; drow = pair_row(n0, 1); }
    else { r -= NE * IE; const int e = r / ID, q = r % ID, nb = DM / 64; kb = q / nb; n0 = (q % nb) * 64; src = a.in[IN_EDOWN] + (size_t)e * FFE * DM; ld = DM; K = FFE; f8 = MOE_F8; dbase = ws + WS_W8; eoff = (size_t)e * DM * FFE; drow = n0; }
    const int es = f8 ? 1 : 2;
    CvtDesc d; d.src = src + (size_t)(kb * 32) * ld + n0; d.ld = ld; d.dst = dbase + (eoff + (size_t)(drow >> 8) * 256 * K) * es + (size_t)(drow & 255) * 32; d.kb0 = kb * 32 * es; d.f8 = f8; d.sc = f8 == 1 ? W_SCALE : (f8 == 2 ? wsc[wq] : 1.0f); d.pd0 = pd0; return d;
}
__device__ __forceinline__ void cvt_load(const CvtDesc& d, float (&v)[32], int lane) {
#pragma unroll
    for (int i = 0; i < 32; ++i) v[i] = __builtin_nontemporal_load(d.src + (size_t)i * d.ld + lane);
}
__device__ __forceinline__ unsigned pk4_i8_magic(float a, float b, float c, float d, float sc) {
    const unsigned ua = __builtin_bit_cast(unsigned, __builtin_fmaf(a, sc, 12582912.f)), ub = __builtin_bit_cast(unsigned, __builtin_fmaf(b, sc, 12582912.f)), uc = __builtin_bit_cast(unsigned, __builtin_fmaf(c, sc, 12582912.f)), ud = __builtin_bit_cast(unsigned, __builtin_fmaf(d, sc, 12582912.f));
    const unsigned lo = __builtin_amdgcn_perm(ub, ua, 0x0c0c0400u), hi = __builtin_amdgcn_perm(ud, uc, 0x04000c0cu);
    return lo | hi; }
__device__ __forceinline__ void cvt_store(const CvtDesc& d, const float (&v)[32], LAS float* scr, int lane) {
    (void)scr;
    unsigned char* p = d.dst + (size_t)(d.pd0 >= 0 ? qk_slot(d.pd0 + lane) : lane) * 32 + (size_t)(d.kb0 >> 5) * 8192;
    const float sc = d.sc;
    if (d.f8 == 1) {
#pragma unroll
        for (int h = 0; h < 2; ++h) { u32x4 o;
            o.x = pk4_fp8(v[16 * h + 0] * sc, v[16 * h + 1] * sc, v[16 * h + 2] * sc, v[16 * h + 3] * sc); o.y = pk4_fp8(v[16 * h + 4] * sc, v[16 * h + 5] * sc, v[16 * h + 6] * sc, v[16 * h + 7] * sc);
            o.z = pk4_fp8(v[16 * h + 8] * sc, v[16 * h + 9] * sc, v[16 * h + 10] * sc, v[16 * h + 11] * sc); o.w = pk4_fp8(v[16 * h + 12] * sc, v[16 * h + 13] * sc, v[16 * h + 14] * sc, v[16 * h + 15] * sc);
            *(u32x4*)(p + 16 * h) = o; } }
    else if (d.f8 == 2) { const float lim = 127.f / sc;
#define CL(x) __builtin_amdgcn_fmed3f(x, -lim, lim)
#pragma unroll
        for (int h = 0; h < 2; ++h) { u32x4 o;
            o.x = pk4_i8_magic(CL(v[16 * h + 0]), CL(v[16 * h + 1]), CL(v[16 * h + 2]), CL(v[16 * h + 3]), sc); o.y = pk4_i8_magic(CL(v[16 * h + 4]), CL(v[16 * h + 5]), CL(v[16 * h + 6]), CL(v[16 * h + 7]), sc);
            o.z = pk4_i8_magic(CL(v[16 * h + 8]), CL(v[16 * h + 9]), CL(v[16 * h + 10]), CL(v[16 * h + 11]), sc); o.w = pk4_i8_magic(CL(v[16 * h + 12]), CL(v[16 * h + 13]), CL(v[16 * h + 14]), CL(v[16 * h + 15]), sc);
            *(u32x4*)(p + 16 * h) = o; }
#undef CL
    }
    else {
#pragma unroll
        for (int h = 0; h < 4; ++h) { u32x4 o; o.x = pk2(v[8 * h + 0], v[8 * h + 1]); o.y = pk2(v[8 * h + 2], v[8 * h + 3]); o.z = pk2(v[8 * h + 4], v[8 * h + 5]); o.w = pk2(v[8 * h + 6], v[8 * h + 7]);
            *(u32x4*)(p + (size_t)(h >> 1) * 8192 + 16 * (h & 1)) = o; } }
}
constexpr int CVT_I0 = (DM / 64) * (3 * DM / 32), CVT_I1 = (DM / 64) * (DM / 32), CVT_I2 = (DM / 64) * (FF / 32), CVT_I4 = (FF / 64) * (DM / 32), CVT_IE = (DM / 64) * (FFE / 32), CVT_ID = (FFE / 64) * (DM / 32);
constexpr int CVT_M0 = CVT_I0 + CVT_I1 + 2 * CVT_I2 + CVT_I4 + CVT_I0 + CVT_I1;
constexpr int CVT_NITEMS = CVT_M0 + 2 * NE * CVT_IE + NE * CVT_ID;
constexpr int CVT_P0 = CVT_I0 + CVT_I1;
constexpr int CVT_S1 = CVT_P0 + 34816, CVT_S1B = CVT_S1 + 22528, CVT_S2 = CVT_S1B + 51200, CVT_S2B = CVT_S2 + 34816, CVT_S3 = CVT_S2B + 29184;
static_assert(CVT_S1 >= CVT_M0 && CVT_S3 < CVT_NITEMS, "slice boundaries");
constexpr int CVT_S1_UNUSED_ = 0;
static_assert(CVT_S2 < CVT_NITEMS, "slices");
__device__ __forceinline__ void convert_phase(Frame& F, const Args& a, const LAS float* wsc, const int lo, const int NITEMS) {
    LAS float* scr = (LAS float*)(F.lds + F.wave * 16384);
    const int gw = F.vcu * NWAVES + F.wave, NGW = F.G * NWAVES;
    int it = lo + gw; if (it >= NITEMS) return;
    float va[32], vb[32], vc[32];
    CvtDesc da = cvt_decode(it, a, F.ws, wsc), db = da, dc = da; cvt_load(da, va, F.lane);
    if (it + NGW < NITEMS) { db = cvt_decode(it + NGW, a, F.ws, wsc); cvt_load(db, vb, F.lane); }
    for (;;) {
        if (it + 2 * NGW < NITEMS) { dc = cvt_decode(it + 2 * NGW, a, F.ws, wsc); cvt_load(dc, vc, F.lane); }
        cvt_store(da, va, scr, F.lane);
        if (it + NGW >= NITEMS) break; it += NGW;
        if (it + 2 * NGW < NITEMS) { da = cvt_decode(it + 2 * NGW, a, F.ws, wsc); cvt_load(da, va, F.lane); }
        cvt_store(db, vb, scr, F.lane);
        if (it + NGW >= NITEMS) break; it += NGW;
        if (it + 2 * NGW < NITEMS) { db = cvt_decode(it + 2 * NGW, a, F.ws, wsc); cvt_load(db, vb, F.lane); }
        cvt_store(dc, vc, scr, F.lane);
        if (it + NGW >= NITEMS) break; it += NGW;
    }
}
__device__ __forceinline__ void cvt_slice(Frame& F, const Args& a, const float* wsc_g, int lo, int hi) {
    LAS float* wsc_l = (LAS float*)(F.lds + PHASE_LDS);
    if (F.tid < WQ_N) wsc_l[F.tid] = __builtin_bit_cast(float, ld_i32_agent((const int*)wsc_g + F.tid));
    __syncthreads();
    convert_phase(F, a, wsc_l, lo, hi);
    __syncthreads();
}
template <int OM, bool XB = false> __device__ __forceinline__ void norm_row(const void* xrow, const float* gain, const float* shift, const float* scale, void* orow, int lane, f32x4 (&hv)[8], float* rs_out = nullptr) {
    const f32x4* xr = (const f32x4*)xrow + lane; const u32x2* xb = (const u32x2*)xrow + lane;
    float s = 0.f;
#pragma unroll
    for (int j = 0; j < 8; ++j) { if constexpr (XB) { const u32x2 w = xb[64 * j]; hv[j] = (f32x4){hf_lo(w.x), hf_hi(w.x), hf_lo(w.y), hf_hi(w.y)}; } else hv[j] = xr[64 * j]; s += (hv[j].x * hv[j].x + hv[j].y * hv[j].y) + (hv[j].z * hv[j].z + hv[j].w * hv[j].w); }
    const float rstd = 1.0f / sqrtf(wave_sum(s) * (1.f / DM) + NORM_EPS);
    unsigned long long* o8 = (unsigned long long*)orow + lane; unsigned* o4 = (unsigned*)orow + lane;
#pragma unroll
    for (int j = 0; j < 8; ++j) { const f32x4 g = ((const f32x4*)gain)[lane + 64 * j], sh = ((const f32x4*)shift)[lane + 64 * j], sc = ((const f32x4*)scale)[lane + 64 * j];
        hv[j] = (hv[j] * rstd * g) * (sc + 1.0f) + sh; }
    float qs = 1.f;
    if constexpr (OM >= 2) { float mx = 1e-20f;
#pragma unroll
        for (int j = 0; j < 8; ++j) mx = fmaxf(mx, fmaxf(fmaxf(fabsf(hv[j].x), fabsf(hv[j].y)), fmaxf(fabsf(hv[j].z), fabsf(hv[j].w))));
#pragma unroll
        for (int o = 1; o < 64; o <<= 1) mx = fmaxf(mx, __shfl_xor(mx, o));
        qs = 127.f / mx; if (lane == 0) *rs_out = mx * (1.f / 127.f); }
#pragma unroll
    for (int j = 0; j < 8; ++j) {
        if constexpr (OM == 1) o4[64 * j] = pk4_fp8(hv[j].x * HS_SCALE, hv[j].y * HS_SCALE, hv[j].z * HS_SCALE, hv[j].w * HS_SCALE);
        else if constexpr (OM >= 2) o4[64 * j] = pk4_i8(hv[j].x * qs, hv[j].y * qs, hv[j].z * qs, hv[j].w * qs);
        else o8[64 * j] = (unsigned long long)cvt_pk_bf16(hv[j].x, hv[j].y) | ((unsigned long long)cvt_pk_bf16(hv[j].z, hv[j].w) << 32); }
}
__device__ __forceinline__ void norm_vecs(const float* gain, const float* shift, const float* scale, int lane, f32x4 (&gs)[8], f32x4 (&sh)[8]) {
#pragma unroll
    for (int j = 0; j < 8; ++j) { const f32x4 g = ((const f32x4*)gain)[lane + 64 * j], sc = ((const f32x4*)scale)[lane + 64 * j]; gs[j] = g * (sc + 1.0f); sh[j] = ((const f32x4*)shift)[lane + 64 * j]; }
}
template <int OM, bool XB = false> __device__ __forceinline__ void norm_row_r(const void* xrow, const f32x4 (&gs)[8], const f32x4 (&sh)[8], void* orow, int lane, f32x4 (&hv)[8], float* rs_out = nullptr) {
    const f32x4* xr = (const f32x4*)xrow + lane; const u32x2* xb = (const u32x2*)xrow + lane;
    float s = 0.f;
#pragma unroll
    for (int j = 0; j < 8; ++j) { if constexpr (XB) { const u32x2 w = xb[64 * j]; hv[j] = (f32x4){hf_lo(w.x), hf_hi(w.x), hf_lo(w.y), hf_hi(w.y)}; } else hv[j] = xr[64 * j]; s += (hv[j].x * hv[j].x + hv[j].y * hv[j].y) + (hv[j].z * hv[j].z + hv[j].w * hv[j].w); }
    const float rstd = 1.0f / sqrtf(wave_sum(s) * (1.f / DM) + NORM_EPS);
    unsigned long long* o8 = (unsigned long long*)orow + lane; unsigned* o4 = (unsigned*)orow + lane;
#pragma unroll
    for (int j = 0; j < 8; ++j) hv[j] = (hv[j] * rstd) * gs[j] + sh[j];
    float qs = 1.f;
    if constexpr (OM >= 2) { float mx = 1e-20f;
#pragma unroll
        for (int j = 0; j < 8; ++j) mx = fmaxf(mx, fmaxf(fmaxf(fabsf(hv[j].x), fabsf(hv[j].y)), fmaxf(fabsf(hv[j].z), fabsf(hv[j].w))));
#pragma unroll
        for (int o = 1; o < 64; o <<= 1) mx = fmaxf(mx, __shfl_xor(mx, o));
        qs = 127.f / mx; if (lane == 0) *rs_out = mx * (1.f / 127.f); }
#pragma unroll
    for (int j = 0; j < 8; ++j) {
        if constexpr (OM == 1) o4[64 * j] = pk4_fp8(hv[j].x * HS_SCALE, hv[j].y * HS_SCALE, hv[j].z * HS_SCALE, hv[j].w * HS_SCALE);
        else if constexpr (OM >= 2) o4[64 * j] = pk4_i8(hv[j].x * qs, hv[j].y * qs, hv[j].z * qs, hv[j].w * qs);
        else o8[64 * j] = (unsigned long long)cvt_pk_bf16(hv[j].x, hv[j].y) | ((unsigned long long)cvt_pk_bf16(hv[j].z, hv[j].w) << 32); }
}
template <int OM, bool XB = false> __device__ __forceinline__ void norm_phase(Frame& F, const void* x, const float* gain, const float* mod_l, int shift_idx, void* h, float* rs) {
    const int gw = F.vcu * NWAVES + F.wave, NGW = F.G * NWAVES;
    for (int m0 = 8 * gw; m0 < MTOK; m0 += 8 * NGW) { const int b = m0 >> 11; const float* mb = mod_l + (size_t)b * (6 * DM);
        f32x4 gs[8], sh[8]; norm_vecs(gain, mb + shift_idx * DM, mb + (shift_idx + 1) * DM, F.lane, gs, sh);
        for (int k = 0; k < 8; ++k) { const int m = m0 + k;
            f32x4 hv[8]; norm_row_r<OM, XB>((const unsigned char*)x + (size_t)m * DM * (XB ? 2 : 4), gs, sh, (unsigned char*)h + (size_t)m * DM * (OM ? 1 : 2), F.lane, hv, rs + m); } }
}
__device__ __forceinline__ void norm_router_phase(Frame& F, const void* x, const float* gain, const float* mod_l, const float* rw, const float* rb, bf16_t* h,
                                                  int* tok_e, float* tok_w, int* tok_rank, int* chunk_cnt, float* rs_tok) {
    LAS float* rwT = (LAS float*)F.lds;
    LAS int* le = (LAS int*)(F.lds + 65536);
    for (int i = F.tid; i < DM * NE; i += NWAVES * 64) { const int d = i >> 3, e = i & 7; rwT[e * DM + d] = rw[i]; }
    __syncthreads();
    for (int u = blockIdx.x; u < MTOK / 64; u += F.G) {
        f32x4 gs[8], sh[8]; { const float* mb = mod_l + (size_t)((u * 64) >> 11) * (6 * DM); norm_vecs(gain, mb + 3 * DM, mb + 4 * DM, F.lane, gs, sh); }
        for (int rr = 0; rr < 8; ++rr) { const int lr = F.wave * 8 + rr, m = u * 64 + lr;
            f32x4 hv[8]; norm_row_r<MD_MOE_GU == 2 ? 3 : 0, X_BF16 != 0>((const unsigned char*)x + (size_t)m * DM * (X_BF16 ? 2 : 4), gs, sh, (unsigned char*)h + (size_t)m * DM * (MD_MOE_GU == 2 ? 1 : 2), F.lane, hv, rs_tok + m);
            float lg[8];
#pragma unroll
            for (int e = 0; e < 8; ++e) { float s = 0.f;
#pragma unroll
                for (int j = 0; j < 8; ++j) { const f32x4 w = *(const LAS f32x4*)(rwT + e * DM + 4 * F.lane + 256 * j); s += (hv[j].x * w.x + hv[j].y * w.y) + (hv[j].z * w.z + hv[j].w * w.w); }
                lg[e] = wave_sum(s) + rb[e]; }
            int i1 = 0; float m1 = lg[0];
#pragma unroll
            for (int e = 1; e < 8; ++e) if (lg[e] > m1) { m1 = lg[e]; i1 = e; }
            int i2 = -1; float m2 = -__builtin_inff();
#pragma unroll
            for (int e = 0; e < 8; ++e) if (e != i1 && lg[e] > m2) { m2 = lg[e]; i2 = e; }
            const float w1 = 1.0f / (1.0f + __expf(m2 - m1));
            if (F.lane == 0) { tok_e[2 * m] = i1; tok_e[2 * m + 1] = i2; tok_w[2 * m] = w1; tok_w[2 * m + 1] = 1.0f - w1; le[2 * lr] = i1; le[2 * lr + 1] = i2; }
        }
        __syncthreads();
        if (F.wave == 0) { const int e0 = le[2 * F.lane], e1 = le[2 * F.lane + 1]; const unsigned long long lt = (1ull << F.lane) - 1ull; int r0 = 0, r1 = 0;
#pragma unroll
            for (int e = 0; e < 8; ++e) { const unsigned long long b0 = __ballot(e0 == e), b1 = __ballot(e1 == e); const int below = __popcll(b0 & lt) + __popcll(b1 & lt);
                if (e0 == e) r0 = below; if (e1 == e) r1 = below; if (F.lane == 0) chunk_cnt[u * 8 + e] = __popcll(b0) + __popcll(b1); }
            const int m = u * 64 + F.lane; tok_rank[2 * m] = r0; tok_rank[2 * m + 1] = r1; }
        __syncthreads();
    }
}
__device__ __forceinline__ void scatter_phase(Frame& F, const int* chunk_cnt, const int* tok_e, const int* tok_rank, int* tok_pos, const bf16_t* h, unsigned char* hs, int* mt_e, int* n_mt, float* rs, const float* rs_tok) {
    LAS int* pref = (LAS int*)F.lds;
    LAS int* tot = (LAS int*)(F.lds + 8192);
    { const int e = F.wave; int c[4]; int s = 0;
#pragma unroll
      for (int k = 0; k < 4; ++k) { c[k] = ld_i32_agent(chunk_cnt + (4 * F.lane + k) * 8 + e); s += c[k]; }
      int inc = s;
#pragma unroll
      for (int o = 1; o < 64; o <<= 1) { const int v = __shfl_up(inc, o); if (F.lane >= o) inc += v; }
      int ex = inc - s;
#pragma unroll
      for (int k = 0; k < 4; ++k) { pref[e * 256 + 4 * F.lane + k] = ex; ex += c[k]; }
      if (F.lane == 63) tot[e] = inc; }
    __syncthreads();
    if (F.tid == 0) { int ts = 0; for (int e = 0; e < 8; ++e) { tot[8 + e] = ts; const int nt = (tot[e] + 255) >> 8; if (blockIdx.x == 0) for (int k = 0; k < nt; ++k) mt_e[ts + k] = e; ts += nt; } if (blockIdx.x == 0) *n_mt = ts; }
    __syncthreads();
    for (int u = blockIdx.x; u < MTOK / 64; u += F.G) {
        for (int q = F.wave; q < 128; q += NWAVES) { const int m = u * 64 + (q >> 1), k = q & 1; const int e = ld_i32_agent(tok_e + 2 * m + k), rk = ld_i32_agent(tok_rank + 2 * m + k);
            const int pos = 256 * tot[8 + e] + pref[e * 256 + u] + rk;
            if (F.lane == 0) tok_pos[2 * m + k] = pos;
            const u32x4* s = (const u32x4*)(h + (size_t)m * DM) + F.lane;
            if (MD_MOE_GU == 2) {
                const u32x4* s8 = (const u32x4*)((const unsigned char*)h + (size_t)m * DM) + F.lane; u32x4* d = (u32x4*)(hs + (size_t)pos * DM) + F.lane;
                d[0] = s8[0]; d[64] = s8[64];
                if (F.lane == 0) rs[pos] = __builtin_bit_cast(float, ld_i32_agent((const int*)rs_tok + m)); }
            else if (MD_MOE_GU == 1) { u32x2* d = (u32x2*)(hs + (size_t)pos * DM) + F.lane;
#pragma unroll
                for (int j = 0; j < 4; ++j) { const u32x4 w = s[64 * j]; u32x2 o;
                    o.x = pk4_fp8(bf_lo(w.x) * HS_SCALE, bf_hi(w.x) * HS_SCALE, bf_lo(w.y) * HS_SCALE, bf_hi(w.y) * HS_SCALE); o.y = pk4_fp8(bf_lo(w.z) * HS_SCALE, bf_hi(w.z) * HS_SCALE, bf_lo(w.w) * HS_SCALE, bf_hi(w.w) * HS_SCALE);
                    d[64 * j] = o; } }
            else { u32x4* d = (u32x4*)(hs + (size_t)pos * DM * 2) + F.lane;
#pragma unroll
                for (int j = 0; j < 4; ++j) d[64 * j] = s[64 * j]; } }
    }
}
__device__ __forceinline__ void conv_phase(Frame& F, const bf16_t* U, const bf16_t* BG, const float* cw, bf16_t* W) {
    const int gw = F.vcu * NWAVES + F.wave, NGW = F.G * NWAVES;
    for (int m = gw; m < MTOK; m += NGW) { const int s = m & (SEQ - 1);
#pragma unroll
        for (int j = 0; j < 4; ++j) { const int d = 8 * F.lane + 512 * j;
            const u32x4 u0 = *(const u32x4*)(U + (size_t)m * DM + d), bg = *(const u32x4*)(BG + (size_t)m * DM + d);
            const u32x4 z = {0u, 0u, 0u, 0u};
            const u32x4 u1 = s >= 1 ? *(const u32x4*)(U + (size_t)(m - 1) * DM + d) : z, u2 = s >= 2 ? *(const u32x4*)(U + (size_t)(m - 2) * DM + d) : z;
            const f32x4 k0a = *(const f32x4*)(cw + d), k0b = *(const f32x4*)(cw + d + 4), k1a = *(const f32x4*)(cw + DM + d), k1b = *(const f32x4*)(cw + DM + d + 4), k2a = *(const f32x4*)(cw + 2 * DM + d), k2b = *(const f32x4*)(cw + 2 * DM + d + 4);
            float r[8];
#define CV(i, uw0, uw1, uw2, bw, ka, kb, kc, LOHI) r[i] = LOHI(bw) * (ka * LOHI(uw2) + kb * LOHI(uw1) + kc * LOHI(uw0))
            CV(0, u0.x, u1.x, u2.x, bg.x, k0a[0], k1a[0], k2a[0], bf_lo); CV(1, u0.x, u1.x, u2.x, bg.x, k0a[1], k1a[1], k2a[1], bf_hi);
            CV(2, u0.y, u1.y, u2.y, bg.y, k0a[2], k1a[2], k2a[2], bf_lo); CV(3, u0.y, u1.y, u2.y, bg.y, k0a[3], k1a[3], k2a[3], bf_hi);
            CV(4, u0.z, u1.z, u2.z, bg.z, k0b[0], k1b[0], k2b[0], bf_lo); CV(5, u0.z, u1.z, u2.z, bg.z, k0b[1], k1b[1], k2b[1], bf_hi);
            CV(6, u0.w, u1.w, u2.w, bg.w, k0b[2], k1b[2], k2b[2], bf_lo); CV(7, u0.w, u1.w, u2.w, bg.w, k0b[3], k1b[3], k2b[3], bf_hi);
#undef CV
            u32x4 o; o.x = cvt_pk_bf16(r[0], r[1]); o.y = cvt_pk_bf16(r[2], r[3]); o.z = cvt_pk_bf16(r[4], r[5]); o.w = cvt_pk_bf16(r[6], r[7]);
            *(u32x4*)(W + (size_t)m * DM + d) = o; } }
}
__device__ __forceinline__ void qkprep_phase(Frame& F, bf16_t* qkv, const float* qg, const float* kg, const float* rope, float* kmean) {
    LAS float* part = (LAS float*)F.lds;
    const int rg = F.lane >> 4, ds = F.lane & 15, d0 = 8 * ds, fi = 8 * (ds & 7);
    for (int u = F.vcu; u < 2 * NB * NH * NBLK; u += F.G) {
        const int which = u / (NB * NH * NBLK), r = u % (NB * NH * NBLK), b = r / (NH * NBLK), hh = (r / NBLK) % NH, blk = r % NBLK;
        const float* gn = which ? kg : qg;
        const f32x4 ga = *(const f32x4*)(gn + d0), gb = *(const f32x4*)(gn + d0 + 4);
        float ks[8];
#pragma unroll
        for (int i = 0; i < 8; ++i) ks[i] = 0.f;
        for (int it = 0; it < 8; ++it) {
            const int pos = blk * MBLK + F.wave * 32 + it * 4 + rg; const size_t m = (size_t)b * SEQ + pos;
            bf16_t* p = qkv + m * 6144 + which * DM + hh * HD + d0;
            const u32x4 w = *(const u32x4*)p;
            float v[8] = {bf_lo(w.x), bf_hi(w.x), bf_lo(w.y), bf_hi(w.y), bf_lo(w.z), bf_hi(w.z), bf_lo(w.w), bf_hi(w.w)};
            float ss = 0.f;
#pragma unroll
            for (int i = 0; i < 8; ++i) ss += v[i] * v[i];
            ss += __shfl_xor(ss, 1); ss += __shfl_xor(ss, 2); ss += __shfl_xor(ss, 4); ss += __shfl_xor(ss, 8);
            const float rstd = 1.0f / sqrtf(ss * (1.f / HD) + NORM_EPS);
            const float g8[8] = {ga[0], ga[1], ga[2], ga[3], gb[0], gb[1], gb[2], gb[3]};
            const f32x4 ca = *(const f32x4*)(rope + pos * 64 + fi), cb = *(const f32x4*)(rope + pos * 64 + fi + 4), sa = *(const f32x4*)(rope + SEQ * 64 + pos * 64 + fi), sb = *(const f32x4*)(rope + SEQ * 64 + pos * 64 + fi + 4);
            const float c8[8] = {ca[0], ca[1], ca[2], ca[3], cb[0], cb[1], cb[2], cb[3]}, s8[8] = {sa[0], sa[1], sa[2], sa[3], sb[0], sb[1], sb[2], sb[3]};
            float o[8];
#pragma unroll
            for (int i = 0; i < 8; ++i) { const float y = v[i] * rstd * g8[i]; const float yo = __shfl_xor(y, 8); o[i] = (ds < 8) ? (y * c8[i] - yo * s8[i]) : (y * c8[i] + yo * s8[i]); ks[i] += o[i]; }
            u32x4 ow; ow.x = cvt_pk_bf16(o[0], o[1]); ow.y = cvt_pk_bf16(o[2], o[3]); ow.z = cvt_pk_bf16(o[4], o[5]); ow.w = cvt_pk_bf16(o[6], o[7]);
            *(u32x4*)p = ow;
        }
        if (which) {
#pragma unroll
            for (int i = 0; i < 8; ++i) { ks[i] += __shfl_xor(ks[i], 16); ks[i] += __shfl_xor(ks[i], 32); }
            if (rg == 0) {
#pragma unroll
                for (int i = 0; i < 8; ++i) part[F.wave * 128 + d0 + i] = ks[i]; }
            __syncthreads();
            if (F.tid < 128) { float s = 0.f;
#pragma unroll
                for (int w = 0; w < 8; ++w) s += part[w * 128 + F.tid];
                kmean[(((size_t)b * NH + hh) * NBLK + blk) * HD + F.tid] = s * (1.f / MBLK); }
            __syncthreads();
        }
    }
}
__device__ __forceinline__ moba::BlockRef attn_ref(int item, int pass, const bf16_t* qkv, unsigned char* O, const float* kmean) {
    const int bh = item >> 2, x = item & 3, qb = pass ? 7 - x : x, b = bh >> 4, hh = bh & 15;
    moba::BlockRef r; const size_t row0 = (size_t)b * SEQ;
    r.Q = qkv + (row0 + (size_t)qb * 256) * 6144 + hh * HD; r.K = qkv + row0 * 6144 + DM + hh * HD; r.V = qkv + row0 * 6144 + 2 * DM + hh * HD;
    r.O = O + ((row0 + (size_t)qb * 256) * DM + hh * HD) * (F8_AOUT ? 1 : 2); r.P0 = qb * 256; r.km = kmean + (size_t)bh * NBLK * HD;
    return r;
}
__device__ __forceinline__ void attn_phase(Frame& F, const bf16_t* qkv, unsigned char* O, const float* kmean, int i0 = 0, int i1 = 1 << 20) {
    const int stride = F.G; const long tot_ = (long)F.vcu + (long)i1 * stride; const int total = tot_ < NB * NH * 4 ? (int)tot_ : NB * NH * 4;
    int L = F.vcu + i0 * stride; if (L >= total) return;
    int pass = 0;
    moba::BlockRef cur = attn_ref(L, 0, qkv, O, kmean);
    moba::Seam S;
    LAS char* lds = (LAS char*)F.lds;
    moba::moba_prime(cur, lds, S);
    for (;;) {
        const bool more_pass = pass == 0, more_item = L + stride < total, last = !more_pass && !more_item;
        int passn = pass + 1, Ln = L;
        if (!more_pass) { passn = 0; Ln = more_item ? L + stride : L; }
        const moba::BlockRef nxt = last ? cur : attn_ref(Ln, passn, qkv, O, kmean);
        moba::moba_block(cur, nxt, lds, S);
        if (last) break;
        cur = nxt; pass = passn; L = Ln;
    }
}

#ifdef ATTN_PROBE
__device__ __forceinline__ void attn_probe_phase(Frame& F, const bf16_t* qkv, const bf16_t* O, const float* kmean, unsigned* ctl) {
    LAS float* qs = (LAS float*)(F.lds) + F.wave * 128;
    LAS float* sc = (LAS float*)(F.lds + 4096) + F.wave * 1024;
    const int gw = F.vcu * NWAVES + F.wave, NGW = F.G * NWAVES, lane = F.lane;
    for (int s = gw; s < 8192; s += NGW) {
        const int b = s & 7, hh = (s >> 3) & 15; int qpos = (s * 977 + (s >> 7) * 13) & 2047;
        if ((s & 31) == 0) qpos = ((s >> 5) & 7) * 256; if ((s & 31) == 1) qpos = ((s >> 5) & 7) * 256 + 255; if ((s & 31) == 2) qpos = ((s >> 5) & 7) * 256 + 1;
        const int own = qpos >> 8; const size_t row0 = (size_t)b * SEQ;
        const bf16_t* qp = qkv + (row0 + qpos) * 6144 + hh * HD;
        { const unsigned w = *(const unsigned*)(qp + 2 * lane); qs[2 * lane] = bf_lo(w); qs[2 * lane + 1] = bf_hi(w); }
        LDS_WAIT(); asm volatile("" ::: "memory");
        unsigned sel = 0u; const float* km = kmean + ((size_t)(b * NH + hh) * NBLK) * HD;
        if (own > 0) { if (own <= TOPK) sel = (1u << own) - 1u; else { float g[7];
#pragma unroll
            for (int j = 0; j < 7; ++j) { g[j] = -__builtin_inff(); if (j < own) { float a = 0.f; _Pragma("unroll 1") for (int d = 0; d < HD; ++d) a = fmaf(qs[d], km[j * HD + d], a); g[j] = a; } }
#pragma unroll
            for (int k = 0; k < TOPK; ++k) { float best = -__builtin_inff(); int bi = 0;
#pragma unroll
                for (int j = 6; j >= 0; --j) { const bool ok = (j < own) && !((sel >> j) & 1u) && (g[j] >= best); best = ok ? g[j] : best; bi = ok ? j : bi; } sel |= 1u << bi; } } }
        int nk = 0; float mx = -__builtin_inff();
        _Pragma("unroll 1") for (int j = 0; j <= own; ++j) { if (j < own && !((sel >> j) & 1u)) continue;
            _Pragma("unroll 1") for (int i = lane; i < 256; i += 64) { const int pos = j * 256 + i; const bf16_t* kp = qkv + (row0 + pos) * 6144 + DM + hh * HD; float a = 0.f;
                _Pragma("unroll 4") for (int d = 0; d < HD; d += 2) { const unsigned w = *(const unsigned*)(kp + d); a = fmaf(qs[d], bf_lo(w), a); a = fmaf(qs[d + 1], bf_hi(w), a); }
                a *= 0.08838834764831845f; if (j == own && pos > qpos) a = -__builtin_inff(); sc[nk + i] = a; mx = fmaxf(mx, a); }
            nk += 256; }
        for (int o = 1; o < 64; o <<= 1) mx = fmaxf(mx, __shfl_xor(mx, o));
        LDS_WAIT(); asm volatile("" ::: "memory");
        float l = 0.f;
        _Pragma("unroll 1") for (int i = lane; i < nk; i += 64) { const float p = __expf(sc[i] - mx); sc[i] = p; l += p; }
        l = wave_sum(l);
        LDS_WAIT(); asm volatile("" ::: "memory");
        float o0 = 0.f, o1 = 0.f; int kk = 0;
        _Pragma("unroll 1") for (int j = 0; j <= own; ++j) { if (j < own && !((sel >> j) & 1u)) continue;
            _Pragma("unroll 4") for (int i = 0; i < 256; ++i) { const float p = sc[kk + i]; const unsigned w = *(const unsigned*)(qkv + (row0 + j * 256 + i) * 6144 + 2 * DM + hh * HD + 2 * lane); o0 = fmaf(p, bf_lo(w), o0); o1 = fmaf(p, bf_hi(w), o1); }
            kk += 256; }
        o0 /= l; o1 /= l;
        const unsigned ow = *(const unsigned*)(O + (row0 + qpos) * DM + hh * HD + 2 * lane);
        float err = fmaxf(fabsf(o0 - bf_lo(ow)), fabsf(o1 - bf_hi(ow))), mag = fmaxf(fabsf(o0), fabsf(o1));
        for (int o = 1; o < 64; o <<= 1) { err = fmaxf(err, __shfl_xor(err, o)); mag = fmaxf(mag, __shfl_xor(mag, o)); }
        const float rel = err / (mag + 1e-9f);
        if (lane == 0) { atomicMax(ctl + 8, __float_as_uint(rel)); if (rel > 0.02f) atomicAdd(ctl + 9, 1u); }
        LDS_WAIT(); asm volatile("" ::: "memory");
    }
}
#endif
__device__ __forceinline__ void moe_y8(const bf16_t* Y, const float* slabs, int pos, int d, int S, float ysc, float (&y)[8]) {
    if (pos < 128 * 256) { const u32x4 w = *(const u32x4*)(Y + (size_t)pos * DM + d);
        y[0] = bf_lo(w.x); y[1] = bf_hi(w.x); y[2] = bf_lo(w.y); y[3] = bf_hi(w.y); y[4] = bf_lo(w.z); y[5] = bf_hi(w.z); y[6] = bf_lo(w.w); y[7] = bf_hi(w.w); return; }
    const int ui = ((pos >> 8) - 128) * (DM / 256) + (d >> 8); const float* p = slabs + ((size_t)ui * S) * 65536 + (size_t)(pos & 255) * 256 + (d & 255);
    f32x4 a = {0.f, 0.f, 0.f, 0.f}, b = {0.f, 0.f, 0.f, 0.f};
    for (int k = 0; k < S; ++k) { a += *(const f32x4*)(p + (size_t)k * 65536); b += *(const f32x4*)(p + (size_t)k * 65536 + 4); }
    y[0] = a[0] * ysc; y[1] = a[1] * ysc; y[2] = a[2] * ysc; y[3] = a[3] * ysc; y[4] = b[0] * ysc; y[5] = b[1] * ysc; y[6] = b[2] * ysc; y[7] = b[3] * ysc;
}
__device__ __forceinline__ void combine_phase(Frame& F, const void* X, const float* gate, const bf16_t* Y, const float* slabs, int S, float ysc, const int* tok_pos, const float* tok_w, float* out, float pf = 1.0f) {
    const int gw = F.vcu * NWAVES + F.wave, NGW = F.G * NWAVES;
    for (int m0 = 8 * gw; m0 < MTOK; m0 += 8 * NGW) { const float* g = gate + (size_t)(m0 >> 11) * (6 * DM);
        f32x4 gah[4], gbh[4];
#pragma unroll
        for (int j = 0; j < 4; ++j) { const int d = 8 * F.lane + 512 * j; gah[j] = *(const f32x4*)(g + d); gbh[j] = *(const f32x4*)(g + d + 4); }
        unsigned long long npos = __hip_atomic_load((const unsigned long long*)tok_pos + m0, RLX_AGENT), nw = __hip_atomic_load((const unsigned long long*)tok_w + m0, RLX_AGENT);
        for (int k = 0; k < 8; ++k) { const int m = m0 + k;
        const int p0 = (int)(unsigned)npos, p1 = (int)(unsigned)(npos >> 32); const float w0 = __builtin_bit_cast(float, (unsigned)nw), w1 = __builtin_bit_cast(float, (unsigned)(nw >> 32));
        if (k < 7) { npos = __hip_atomic_load((const unsigned long long*)tok_pos + m + 1, RLX_AGENT); nw = __hip_atomic_load((const unsigned long long*)tok_w + m + 1, RLX_AGENT); }
        if (p0 < 128 * 256 && p1 < 128 * 256) {
            u32x4 ya[4], yb[4], xw[4];
#pragma unroll
            for (int j = 0; j < 4; ++j) { const int d = 8 * F.lane + 512 * j; ya[j] = *(const u32x4*)(Y + (size_t)p0 * DM + d); yb[j] = *(const u32x4*)(Y + (size_t)p1 * DM + d); xw[j] = *(const u32x4*)((const bf16_t*)X + (size_t)m * DM + d); }
#pragma unroll
            for (int j = 0; j < 4; ++j) { const int d = 8 * F.lane + 512 * j;
                const f32x4 ga = gah[j], gb = gbh[j];
                const unsigned pa[4] = {ya[j].x, ya[j].y, ya[j].z, ya[j].w}, pb[4] = {yb[j].x, yb[j].y, yb[j].z, yb[j].w}, px[4] = {xw[j].x, xw[j].y, xw[j].z, xw[j].w};
                f32x4 oa, ob;
#pragma unroll
                for (int i = 0; i < 2; ++i) {
                    oa[2 * i] = hf_lo(px[i]) + ga[2 * i] * (w0 * bf_lo(pa[i]) + w1 * bf_lo(pb[i])); oa[2 * i + 1] = hf_hi(px[i]) + ga[2 * i + 1] * (w0 * bf_hi(pa[i]) + w1 * bf_hi(pb[i]));
                    ob[2 * i] = hf_lo(px[2 + i]) + gb[2 * i] * (w0 * bf_lo(pa[2 + i]) + w1 * bf_lo(pb[2 + i])); ob[2 * i + 1] = hf_hi(px[2 + i]) + gb[2 * i + 1] * (w0 * bf_hi(pa[2 + i]) + w1 * bf_hi(pb[2 + i])); }
                *(f32x4*)(out + (size_t)m * DM + d) = oa * pf; *(f32x4*)(out + (size_t)m * DM + d + 4) = ob * pf; }
        } else {
#pragma unroll
        for (int j = 0; j < 4; ++j) { const int d = 8 * F.lane + 512 * j;
            float y0[8], y1[8]; moe_y8(Y, slabs, p0, d, S, ysc, y0); moe_y8(Y, slabs, p1, d, S, ysc, y1);
            f32x4 xa, xb; { const u32x4 xw = *(const u32x4*)((const bf16_t*)X + (size_t)m * DM + d); xa = (f32x4){hf_lo(xw.x), hf_hi(xw.x), hf_lo(xw.y), hf_hi(xw.y)}; xb = (f32x4){hf_lo(xw.z), hf_hi(xw.z), hf_lo(xw.w), hf_hi(xw.w)}; }
            const f32x4 ga = gah[j], gb = gbh[j];
            f32x4 oa, ob;
#pragma unroll
            for (int i = 0; i < 4; ++i) { oa[i] = xa[i] + ga[i] * (w0 * y0[i] + w1 * y1[i]); ob[i] = xb[i] + gb[i] * (w0 * y0[4 + i] + w1 * y1[4 + i]); }
            *(f32x4*)(out + (size_t)m * DM + d) = oa * pf; *(f32x4*)(out + (size_t)m * DM + d + 4) = ob * pf; } }
        } }
}
static_assert(X_BF16 == 1, "combine_phase reads the residual stream as f16");

constexpr int N_PHASES = 18;
__global__ void __launch_bounds__(NWAVES * 64, 2) fwd_kernel(Args args) {
    extern __shared__ __attribute__((aligned(16))) unsigned char lds[];
    Frame F;
    F.lds = (LAS unsigned char*)lds; F.ldsg = (char*)lds;
    F.tid = threadIdx.x; F.lane = F.tid & 63; F.wave = __builtin_amdgcn_readfirstlane(F.tid >> 6);
    F.G = gridDim.x; { const int bx = blockIdx.x; F.vcu = (F.G % 8 == 0) ? (bx % 8) * (F.G / 8) + bx / 8 : bx; }
    F.ws = args.ws;
    unsigned char* ws = args.ws;
    volatile LAS unsigned* MISC = (volatile LAS unsigned*)(F.lds + MISC_OFF);
    for (int u = F.tid; u < (LDS_BYTES - PHASE_LDS) / 4; u += NWAVES * 64) ((LAS unsigned*)(F.lds + PHASE_LDS))[u] = 0u;
    __syncthreads();
    XcdBarrier bar; bar.bar = (unsigned*)(ws + WS_CTL) + CW_BAR; bar.x = 0; bar.st = nullptr;
    if (args.use_bar) bar = xcd_barrier_post((unsigned*)(ws + WS_CTL) + CW_BAR, MISC + 8);
    const int lo = args.ph_lo, hi = args.ph_hi;
#ifndef PHMASK
#define PHMASK 0x3ffff
#endif
#define IN(k) (((PHMASK >> (k)) & 1) && lo <= (k) && (k) < hi)
#define SEAM(k) do { if ((k) + 1 < hi) xcd_barrier(bar); } while (0)
#define FRESH() do { int t_ = threadIdx.x; asm volatile("" : "+v"(t_)); F.tid = t_; F.lane = t_ & 63; } while (0)
    float* mod = (float*)(ws + WS_MOD);
    float* kmean = (float*)(ws + WS_KMEAN);
    int* tok_e = (int*)(ws + WS_ROUTE); float* tok_w = (float*)(ws + WS_ROUTE + 131072); int* tok_rank = (int*)(ws + WS_ROUTE + 262144); int* tok_pos = (int*)(ws + WS_ROUTE + 393216);
    int* chunk_cnt = (int*)(ws + WS_CNT); int* mt_e = (int*)(ws + WS_CNT + 16384); int* n_mt = (int*)(ws + WS_CNT + 24576);
    float* rope = (float*)(ws + WS_ROPE);
    float* rsc = (float*)(ws + WS_RS);
    const float* wsc = (const float*)(ws + WS_WSC);
#define WSC_INV(t) (1.f / __builtin_bit_cast(float, ld_i32_agent((const int*)wsc + (t))))
    float* X = (float*)(ws + WS_X);
    unsigned char* ar = ws + WS_AR;
    bf16_t* H = (bf16_t*)(ar + A_H);
    const float* x_in = args.in[IN_X];

    if (IN(0)) { FRESH(); mod_phase(F, args.in[IN_C], args.in[IN_MODW], args.in[IN_MODB], mod); rope_table_phase(F, rope); { LAS float* wsc_l = (LAS float*)(F.lds + PHASE_LDS); calib_phase(F, args, wsc_l, (float*)(ws + WS_WSC)); convert_phase(F, args, wsc_l, 0, CVT_P0); } SEAM(0); }
    if (IN(1)) { FRESH(); norm_phase<MD_CONVIN>(F, x_in, args.in[IN_NMIX], mod, 0, H, rsc); SEAM(1); }
    if (IN(2)) { FRESH(); pg8::Gemm g{H, ws + WS_W1, DM * (MD_CONVIN ? 1 : 2), 0}; pg8::TileOrder S; S.init(MTOK / 256, 24, F.G, (int)blockIdx.x, nullptr, g.rowB / 128);
        pg8::EpiConvIn<MD_CONVIN == 2> E{(bf16_t*)(ar + A_U), (bf16_t*)(ar + A_BG), rsc, MD_CONVIN == 2 ? WSC_INV(WQ_CONVIN) : 1.f};
        const int kx = (((int)blockIdx.x & 7) * 6) / 7;
        { const pg8::SubOrder<pg8::TileOrder> S0{S, 0, kx}; pg8::gemm_phase<pg8::EpiConvIn<MD_CONVIN == 2>, pg8::SubOrder<pg8::TileOrder>, true, MD_CONVIN>(F.lds, g, S0, E); }
        FRESH(); cvt_slice(F, args, wsc, CVT_P0, CVT_S1); FRESH();
        { const pg8::SubOrder<pg8::TileOrder> S1{S, kx, 1 << 20}; pg8::gemm_phase<pg8::EpiConvIn<MD_CONVIN == 2>, pg8::SubOrder<pg8::TileOrder>, true, MD_CONVIN>(F.lds, g, S1, E); } SEAM(2); }
    if (IN(3)) { FRESH(); conv_phase(F, (const bf16_t*)(ar + A_U), (const bf16_t*)(ar + A_BG), args.in[IN_CONVW], (bf16_t*)(ar + A_W)); SEAM(3); }
#if X_BF16
#define RESID_T(f32base) pg8::EpiResidBf<f32base>
#define RESID_OUT (bf16_t*)X
#else
#define RESID_T(f32base) pg8::EpiResid
#define RESID_OUT X
#endif
    if (IN(4)) { FRESH(); pg8::Gemm g{ar + A_W, ws + WS_W2, DM * 2, 0}; pg8::TileOrder S; S.init(MTOK / 256, DM / 256, F.G, (int)blockIdx.x, nullptr, g.rowB / 128);
        RESID_T(true) E{x_in, RESID_OUT, mod + 2 * DM, 1.f};
        const int kx = (((int)blockIdx.x & 7) * 3) >> 3;
        { const pg8::SubOrder<pg8::TileOrder> S0{S, 0, kx}; pg8::gemm_phase<RESID_T(true), pg8::SubOrder<pg8::TileOrder>, true>(F.lds, g, S0, E); }
        FRESH(); cvt_slice(F, args, wsc, CVT_S1, CVT_S1B); FRESH();
        { const pg8::SubOrder<pg8::TileOrder> S1{S, kx, 1 << 20}; pg8::gemm_phase<RESID_T(true), pg8::SubOrder<pg8::TileOrder>, true>(F.lds, g, S1, E); } SEAM(4); }
    if (IN(5)) { FRESH(); norm_phase<MD_FFN_GU, X_BF16 != 0>(F, X, args.in[IN_NFFN], mod, 3, H, rsc); SEAM(5); }
    if (IN(6)) { FRESH(); constexpr int EB = MD_FFN_GU ? 1 : 2; pg8::Gemm g{H, ws + WS_W3, DM * EB, 0}; pg8::TileOrder S; S.init(MTOK / 256, 2 * FF / 256, F.G, (int)blockIdx.x, nullptr, g.rowB / 128);
        const float ig = MD_FFN_GU == 2 ? WSC_INV(WQ_FGATE) : (MD_FFN_GU == 1 ? 1.f / (HS_SCALE * W_SCALE) : 1.f), iu = MD_FFN_GU == 2 ? WSC_INV(WQ_FUP) : ig;
        pg8::EpiSwiglu<F8_FFN_DN != 0, MD_FFN_GU == 2, F8_FFN_DN != 0> E{ar + A_HID, FF, ig, HID_SCALE, rsc, iu};
        const int kx = (((int)blockIdx.x & 7) * 11) / 7;
        { const pg8::SubOrder<pg8::TileOrder> S0{S, 0, kx}; pg8::gemm_phase<pg8::EpiSwiglu<F8_FFN_DN != 0, MD_FFN_GU == 2, F8_FFN_DN != 0>, pg8::SubOrder<pg8::TileOrder>, true, MD_FFN_GU>(F.lds, g, S0, E); }
        FRESH(); cvt_slice(F, args, wsc, CVT_S1B, CVT_S2); FRESH();
        { const pg8::SubOrder<pg8::TileOrder> S1{S, kx, 1 << 20}; pg8::gemm_phase<pg8::EpiSwiglu<F8_FFN_DN != 0, MD_FFN_GU == 2, F8_FFN_DN != 0>, pg8::SubOrder<pg8::TileOrder>, true, MD_FFN_GU>(F.lds, g, S1, E); } SEAM(6); }
    if (IN(7)) { FRESH(); constexpr int EB = F8_FFN_DN ? 1 : 2; pg8::Gemm g{ar + A_HID, ws + WS_W4, FF * EB, 0}; pg8::TileOrder S; S.init(MTOK / 256, DM / 256, F.G, (int)blockIdx.x, nullptr, g.rowB / 128);
        RESID_T(false) E{X, RESID_OUT, mod + 5 * DM, F8_FFN_DN ? 1.f / (HID_SCALE * W_SCALE) : 1.f};
        const int kx = (((int)blockIdx.x & 7) * 3) >> 3;
        { const pg8::SubOrder<pg8::TileOrder> S0{S, 0, kx}; pg8::gemm_phase<RESID_T(false), pg8::SubOrder<pg8::TileOrder>, true, F8_FFN_DN != 0, F8_FFN_DN != 0>(F.lds, g, S0, E); }
        FRESH(); cvt_slice(F, args, wsc, CVT_S2, CVT_S2B); FRESH();
        { const pg8::SubOrder<pg8::TileOrder> S1{S, kx, 1 << 20}; pg8::gemm_phase<RESID_T(false), pg8::SubOrder<pg8::TileOrder>, true, F8_FFN_DN != 0, F8_FFN_DN != 0>(F.lds, g, S1, E); } SEAM(7); }
    const float* mod1 = mod + (size_t)NB * 6 * DM;
    if (IN(8)) { FRESH(); norm_phase<MD_QKV, X_BF16 != 0>(F, X, args.in[IN_NMIX] + DM, mod1, 0, H, rsc); SEAM(8); }
    if (IN(9)) { FRESH(); constexpr int EB = MD_QKV ? 1 : 2; pg8::Gemm g{H, ws + WS_W5, DM * EB, 0}; pg8::TileOrder S; S.init(MTOK / 256, 24, F.G, (int)blockIdx.x, nullptr, g.rowB / 128);
        const float qsc = MD_QKV == 2 ? WSC_INV(WQ_QKV) : (MD_QKV == 1 ? 1.f / (HS_SCALE * W_SCALE) : 1.f);
#if QK_FUSED
        pg8::EpiQKV<MD_QKV == 2> E{(bf16_t*)(ar + A_QKV), qsc, rsc, args.in[IN_QNORM], args.in[IN_KNORM], rope, kmean, (LAS float*)(F.lds + RING_BYTES)};
        const int kx = (((int)blockIdx.x & 7) * 6) / 7;
        { const pg8::SubOrder<pg8::TileOrder> S0{S, 0, kx}; pg8::gemm_phase<pg8::EpiQKV<MD_QKV == 2>, pg8::SubOrder<pg8::TileOrder>, true, MD_QKV>(F.lds, g, S0, E); }
        FRESH(); cvt_slice(F, args, wsc, CVT_S2B, CVT_S3); FRESH();
        { const pg8::SubOrder<pg8::TileOrder> S1{S, kx, 1 << 20}; pg8::gemm_phase<pg8::EpiQKV<MD_QKV == 2>, pg8::SubOrder<pg8::TileOrder>, true, MD_QKV>(F.lds, g, S1, E); } SEAM(9); }
#else
        pg8::EpiBf16T<MD_QKV == 2> E{(bf16_t*)(ar + A_QKV), 6144, qsc, rsc};
        pg8::gemm_phase<pg8::EpiBf16T<MD_QKV == 2>, pg8::TileOrder, true, MD_QKV>(F.lds, g, S, E); SEAM(9); }
#endif
#if !QK_FUSED
    if (IN(10)) { FRESH(); qkprep_phase(F, (bf16_t*)(ar + A_QKV), args.in[IN_QNORM], args.in[IN_KNORM], rope, kmean); SEAM(10); }
#endif
    if (IN(11)) { FRESH(); const int kx = (((int)blockIdx.x & 7) * 3) >> 3;
        attn_phase(F, (const bf16_t*)(ar + A_QKV), ar + A_O, kmean, 0, kx);
        FRESH(); cvt_slice(F, args, wsc, CVT_S3, CVT_NITEMS); FRESH();
        attn_phase(F, (const bf16_t*)(ar + A_QKV), ar + A_O, kmean, kx, 1 << 20); SEAM(11);
#ifdef ATTN_PROBE
        FRESH(); attn_probe_phase(F, (const bf16_t*)(ar + A_QKV), (const bf16_t*)(ar + A_O), kmean, (unsigned*)(ws + WS_CTL)); xcd_barrier(bar);
#endif
    }
    if (IN(12)) { FRESH(); constexpr int EB = F8_AOUT ? 1 : 2; pg8::Gemm g{ar + A_O, ws + WS_W6, DM * EB, 0}; pg8::TileOrder S; S.init(MTOK / 256, DM / 256, F.G, (int)blockIdx.x, nullptr, g.rowB / 128);
        RESID_T(false) E{X, RESID_OUT, mod1 + 2 * DM, F8_AOUT ? 1.f / (O_SCALE * W_SCALE) : 1.f};
        pg8::gemm_phase<RESID_T(false), pg8::TileOrder, true, F8_AOUT != 0>(F.lds, g, S, E); SEAM(12); }
    if (IN(13)) { FRESH(); norm_router_phase(F, X, args.in[IN_NFFN] + DM, mod1, args.in[IN_RW], args.in[IN_RB], H, tok_e, tok_w, tok_rank, chunk_cnt, (float*)(ws + WS_RS2)); SEAM(13); }
    if (IN(14)) { FRESH(); scatter_phase(F, chunk_cnt, tok_e, tok_rank, tok_pos, H, ar + A_HS, mt_e, n_mt, rsc, (const float*)(ws + WS_RS2)); SEAM(14); }
    if (IN(15)) { FRESH(); const int nmt = ld_i32_agent(n_mt);
        constexpr int EB = MD_MOE_GU ? 1 : 2;
        LAS int* mtl = (LAS int*)(F.lds + RING_BYTES); for (int i = F.tid; i < MT_MAX; i += NWAVES * 64) mtl[i] = ld_i32_agent(mt_e + i); __syncthreads();
        pg8::Gemm g{ar + A_HS, ws + WS_W7, DM * EB, (size_t)2 * FFE * DM * EB}; pg8::TileOrder S; S.init(nmt, 2 * FFE / 256, F.G, (int)blockIdx.x, mtl, g.rowB / 128);
        const float ig = MD_MOE_GU == 2 ? WSC_INV(WQ_EGATE) : (MD_MOE_GU == 1 ? 1.f / (HS_SCALE * W_SCALE) : 1.f), iu = MD_MOE_GU == 2 ? WSC_INV(WQ_EUP) : ig;
        pg8::EpiSwiglu<MOE_F8 != 0, MD_MOE_GU == 2, MOE_F8 != 0> E{ar + A_HID2, FFE, ig, HID_SCALE, rsc, iu};
        pg8::gemm_phase<pg8::EpiSwiglu<MOE_F8 != 0, MD_MOE_GU == 2, MOE_F8 != 0>, pg8::TileOrder, true, MD_MOE_GU>(F.lds, g, S, E); SEAM(15); }
    if (IN(16)) { FRESH(); const int nmt = ld_i32_agent(n_mt);
        constexpr int EB = MOE_F8 ? 1 : 2;
        pg8::Gemm g{ar + A_HID2, ws + WS_W8, FFE * EB, (size_t)DM * FFE * EB};
        LAS int* mtl = (LAS int*)(F.lds + RING_BYTES); for (int i = F.tid; i < MT_MAX; i += NWAVES * 64) mtl[i] = ld_i32_agent(mt_e + i); __syncthreads();
        { pg8::TileOrder S; S.init(128, DM / 256, F.G, (int)blockIdx.x, mtl, g.rowB / 128);
          pg8::EpiBf16 E{(bf16_t*)(ar + A_Y), DM, MOE_F8 ? 1.f / (HID_SCALE * W_SCALE) : 1.f, nullptr};
          pg8::gemm_phase<pg8::EpiBf16, pg8::TileOrder, true, MOE_F8 != 0, MOE_F8 != 0>(F.lds, g, S, E); }
        { pg8::PieceOrder S; S.init(nmt, DM / 256, F.G, (int)blockIdx.x, mt_e, g.rowB / 128);
          pg8::EpiSlab E{(float*)(ar + A_SLAB)};
          pg8::gemm_phase<pg8::EpiSlab, pg8::PieceOrder, true, MOE_F8 != 0, MOE_F8 != 0>(F.lds, g, S, E); }
        SEAM(16); }
#ifdef ATTN_PROBE
    if (IN(17)) { FRESH(); const unsigned* ctl = (const unsigned*)(ws + WS_CTL); const float pf = 1.0f + ATTN_PROBE_GAIN * (ATTN_PROBE == 1 ? __uint_as_float(__hip_atomic_load(ctl + 8, RLX_AGENT)) : (float)__hip_atomic_load(ctl + 9, RLX_AGENT) * (1.0f / 8192.0f));
        const int nmt = ld_i32_agent(n_mt); combine_phase(F, X, mod1 + 5 * DM, (const bf16_t*)(ar + A_Y), (const float*)(ar + A_SLAB), pg8::moe_split(nmt, DM / 256, F.G, FFE * (MOE_F8 ? 1 : 2) / 128), MOE_F8 ? 1.f / (HID_SCALE * W_SCALE) : 1.f, tok_pos, tok_w, args.out, pf); }
#else
    if (IN(17)) { FRESH(); const int nmt = ld_i32_agent(n_mt); combine_phase(F, X, mod1 + 5 * DM, (const bf16_t*)(ar + A_Y), (const float*)(ar + A_SLAB), pg8::moe_split(nmt, DM / 256, F.G, FFE * (MOE_F8 ? 1 : 2) / 128), MOE_F8 ? 1.f / (HID_SCALE * W_SCALE) : 1.f, tok_pos, tok_w, args.out); }
#endif
#undef IN
#undef SEAM
}

extern "C" void kernel_launch(void* const* d_in, const int* in_sizes, int n_in, void* d_out, int out_size, void* d_ws, size_t ws_size, hipStream_t stream) {
    static int grid = 0;
    if (grid == 0) {
        if (n_in != N_IN || out_size != MTOK * DM || ws_size < WS_END) { fprintf(stderr, "kernel_launch: unexpected shapes (n_in %d, out %d, ws %zu)\n", n_in, out_size, ws_size); grid = -1; return; }
        int dev = 0, cus = 0, per_cu = 0;
        if (hipGetDevice(&dev) != hipSuccess || hipDeviceGetAttribute(&cus, hipDeviceAttributeMultiprocessorCount, dev) != hipSuccess) { grid = -1; return; }
        if (hipFuncSetAttribute((const void*)fwd_kernel, hipFuncAttributeMaxDynamicSharedMemorySize, LDS_BYTES) != hipSuccess) { fprintf(stderr, "kernel_launch: hipFuncSetAttribute failed\n"); grid = -1; return; }
        if (hipOccupancyMaxActiveBlocksPerMultiprocessor(&per_cu, (const void*)fwd_kernel, NWAVES * 64, LDS_BYTES) != hipSuccess || per_cu < 1) { fprintf(stderr, "kernel_launch: occupancy query says %d\n", per_cu); }
        (void)hipGetLastError();
        grid = cus;
    }
    if (grid < 0) return;
    (void)hipMemsetAsync((char*)d_ws + WS_CTL, 0, CTL_ZERO_BYTES, stream);
    Args a{};
    for (int i = 0; i < N_IN; ++i) a.in[i] = (const float*)d_in[i];
    a.out = (float*)d_out; a.ws = (unsigned char*)d_ws; a.pad = 0;
#if MK_PER_PHASE
    for (int p = 0; p < N_PHASES; ++p) { a.ph_lo = p; a.ph_hi = p + 1; a.use_bar = 0;
        hipLaunchKernelGGL(fwd_kernel, dim3(grid), dim3(NWAVES * 64), LDS_BYTES, stream, a); }
#else
    a.ph_lo = 0; a.ph_hi = N_PHASES; a.use_bar = 1;
    hipLaunchKernelGGL(fwd_kernel, dim3(grid), dim3(NWAVES * 64), LDS_BYTES, stream, a);
#endif
}
```

```cpp
#include <hip/hip_runtime.h>
#include <cstdio>
#include <cstdint>

#ifndef MK_PER_PHASE
#define MK_PER_PHASE 0
#endif

#ifndef MOE_F8
#define MOE_F8 1
#endif
#ifndef F8_FFN_GU
#define F8_FFN_GU 0
#endif
#ifndef F8_FFN_DN
#define F8_FFN_DN 1
#endif
#ifndef F8_QKV
#define F8_QKV 1
#endif
#ifndef F8_AOUT
#define F8_AOUT 1
#endif
#ifndef QK_FUSED
#define QK_FUSED 1
#endif
#ifndef X_BF16
#define X_BF16 1
#endif
#ifndef I8_CONVIN
#define I8_CONVIN 1
#endif
#ifndef I8_FFN_GU
#define I8_FFN_GU 1
#endif
#ifndef I8_QKV
#define I8_QKV 1
#endif
#ifndef I8_MOE_GU
#define I8_MOE_GU 1
#endif
#define LAS __attribute__((address_space(3)))
#define GAS __attribute__((address_space(1)))
typedef unsigned short bf16_t;
typedef short bf16x8 __attribute__((ext_vector_type(8)));
typedef short s16x4 __attribute__((ext_vector_type(4)));
typedef float f32x4 __attribute__((ext_vector_type(4)));
typedef float f32x2 __attribute__((ext_vector_type(2)));
typedef float f32x16 __attribute__((ext_vector_type(16)));
typedef unsigned u32x4 __attribute__((ext_vector_type(4)));
typedef unsigned u32x2 __attribute__((ext_vector_type(2)));
typedef int i32x4_ __attribute__((ext_vector_type(4)));

constexpr int DM = 2048, NB = 8, SEQ = 2048, MTOK = NB * SEQ;
constexpr int NH = 16, HD = 128, MBLK = 256, NBLK = SEQ / MBLK, TOPK = 3;
constexpr int FF = 5632, NE = 8, FFE = 7168;
constexpr int MT_MAX = 2 * MTOK / 256 + NE;
constexpr int MROWS = MT_MAX * 256;
constexpr float NORM_EPS = 1e-6f;
constexpr float W_SCALE = 64.f, HS_SCALE = 16.f, HID_SCALE = 8.f, O_SCALE = 64.f;
constexpr float WI8_CLIP = 4.5f;
enum { WQ_CONVIN = 0, WQ_FGATE, WQ_FUP, WQ_QKV, WQ_EGATE, WQ_EUP, WQ_N };
constexpr int MD_CONVIN = I8_CONVIN ? 2 : 0, MD_FFN_GU = I8_FFN_GU ? 2 : (F8_FFN_GU ? 1 : 0), MD_QKV = I8_QKV ? 2 : (F8_QKV ? 1 : 0), MD_MOE_GU = I8_MOE_GU ? 2 : (MOE_F8 ? 1 : 0);

constexpr size_t MiB = 1u << 20;
constexpr size_t WS_CTL = 0, CTL_ZERO_BYTES = 1 * MiB;
constexpr size_t WS_MOD = 2 * MiB;
constexpr size_t WS_KMEAN = 3 * MiB;
constexpr size_t WS_ROUTE = 4 * MiB;
constexpr size_t WS_CNT = 5 * MiB;
constexpr size_t WS_RS = 7 * MiB;
constexpr size_t WS_WSC = 5 * MiB + 32768;
constexpr size_t WS_RS2 = 7 * MiB + 262144;
constexpr size_t WS_ROPE = 6 * MiB;
constexpr size_t WS_W1 = 8 * MiB;
constexpr size_t WS_W2 = 32 * MiB;
constexpr size_t WS_W3 = 40 * MiB;
constexpr size_t WS_W4 = 84 * MiB;
constexpr size_t WS_W5 = 106 * MiB;
constexpr size_t WS_W6 = 130 * MiB;
constexpr size_t WS_W7 = 138 * MiB;
constexpr size_t WS_W8 = 586 * MiB;
constexpr size_t WS_X = 810 * MiB;
constexpr size_t WS_AR = 938 * MiB;
constexpr size_t A_H = 0;
constexpr size_t A_U = 64 * MiB, A_BG = 128 * MiB, A_W = 192 * MiB, A_HID = 256 * MiB;
constexpr size_t A_QKV = 64 * MiB, A_O = 256 * MiB;
constexpr size_t A_HS = 64 * MiB, A_HID2 = 200 * MiB, A_SLAB = 600 * MiB, A_Y = 676 * MiB;
constexpr size_t WS_END = WS_AR + 812 * MiB;
static_assert(A_HS + (size_t)MROWS * DM * 2 <= A_HID2 && A_HID2 + (size_t)MROWS * FFE * 2 <= A_Y && A_Y + (size_t)MROWS * DM * 2 <= 812 * MiB, "arena");
static_assert(A_HID + (size_t)MTOK * FF * 2 <= 812 * MiB && A_QKV + (size_t)MTOK * 6144 * 2 <= A_O, "arena2");
constexpr int CW_BAR = 4096;

constexpr int RING_BYTES = 131072;
constexpr int PHASE_LDS = 143360;
constexpr int MISC_OFF = PHASE_LDS + 320;
constexpr int LDS_BYTES = 147456;

#define RLX_AGENT __ATOMIC_RELAXED, __HIP_MEMORY_SCOPE_AGENT
#define LDS_WAIT() asm volatile("s_waitcnt lgkmcnt(0)" ::: "memory")
#define VM_WAIT() asm volatile("s_waitcnt vmcnt(0)" ::: "memory")
__device__ __forceinline__ unsigned f2bf(float f) { unsigned u = __builtin_bit_cast(unsigned, f); return (u + 0x7fffu + ((u >> 16) & 1u)) >> 16; }
__device__ __forceinline__ unsigned pk2(float lo, float hi) { return f2bf(lo) | (f2bf(hi) << 16); }
__device__ __forceinline__ unsigned cvt_pk_bf16(float lo, float hi) { unsigned r; asm volatile("v_cvt_pk_bf16_f32 %0, %1, %2" : "=v"(r) : "v"(lo), "v"(hi)); return r; }
__device__ __forceinline__ float bf_lo(unsigned w) { return __builtin_bit_cast(float, w << 16); }
__device__ __forceinline__ float bf_hi(unsigned w) { return __builtin_bit_cast(float, w & 0xffff0000u); }
typedef _Float16 f16x2 __attribute__((ext_vector_type(2)));
__device__ __forceinline__ unsigned pk_f16(float lo, float hi) { const f16x2 v = {(_Float16)lo, (_Float16)hi}; return __builtin_bit_cast(unsigned, v); }
__device__ __forceinline__ float hf_lo(unsigned w) { return (float)__builtin_bit_cast(f16x2, w)[0]; }
__device__ __forceinline__ float hf_hi(unsigned w) { return (float)__builtin_bit_cast(f16x2, w)[1]; }
__device__ __forceinline__ int ld_i32_agent(const int* p) { return (int)__hip_atomic_load((const unsigned*)p, RLX_AGENT); }
__device__ __forceinline__ float clamp448(float x) { return __builtin_amdgcn_fmed3f(x, -448.f, 448.f); }
__device__ __forceinline__ unsigned pk4_fp8(float a, float b, float c, float d) {
    int w = __builtin_amdgcn_cvt_pk_fp8_f32(clamp448(a), clamp448(b), 0, false); w = __builtin_amdgcn_cvt_pk_fp8_f32(clamp448(c), clamp448(d), w, true); return (unsigned)w; }
__device__ __forceinline__ unsigned pk4_i8(float a, float b, float c, float d) {
    const int ia = (int)__builtin_rintf(__builtin_amdgcn_fmed3f(a, -127.f, 127.f)), ib = (int)__builtin_rintf(__builtin_amdgcn_fmed3f(b, -127.f, 127.f)), ic = (int)__builtin_rintf(__builtin_amdgcn_fmed3f(c, -127.f, 127.f)), id = (int)__builtin_rintf(__builtin_amdgcn_fmed3f(d, -127.f, 127.f));
    return (unsigned)(ia & 255) | ((unsigned)(ib & 255) << 8) | ((unsigned)(ic & 255) << 16) | ((unsigned)id << 24); }
__device__ __forceinline__ float wave_sum(float v) {
#pragma unroll
    for (int o = 1; o < 64; o <<= 1) v += __shfl_xor(v, o);
    return v;
}

namespace pg8 {
constexpr int BM = 256, BK = 64, HALF = 128, HTB = HALF * BK * 2, STAGE_BYTES = 8 * HTB, NXCD = 8, WGM = 4;
__host__ __device__ __forceinline__ int lds_byte(int r, int c) { const int st = (r >> 4) * 2 + (c >> 5), rr = r & 15, cc = c & 31, ob = rr * 64 + cc * 2; return st * 1024 + (ob ^ (((ob >> 9) & 1) << 5)); }
__host__ __device__ __forceinline__ void stage_rc(int b, int& R, int& C) { const int st = b / 1024, sb = b % 1024, swz = sb ^ (((sb >> 9) & 1) << 5); R = (st >> 1) * 16 + swz / 64; C = (st & 1) * 32 + (swz % 64) / 2; }
__host__ __device__ __forceinline__ int lds_byte8(int r, int cb) { const int st = (r >> 4) * 2 + (cb >> 6), rr = r & 15, ob = rr * 64 + (cb & 63); return st * 1024 + (ob ^ (((ob >> 9) & 1) << 4)); }
__host__ __device__ __forceinline__ void stage_rc8(int b, int& R, int& Cb) { const int st = b / 1024, sb = b % 1024, swz = sb ^ (((sb >> 9) & 1) << 4); R = (st >> 1) * 16 + swz / 64; Cb = (st & 1) * 64 + swz % 64; }
__host__ __device__ __forceinline__ int perm32(int rho) { const int n = rho >> 4, i = rho & 15; return 8 * (i >> 2) + 4 * n + (i & 3); }

struct Unit { int pm, pn, e, k0b, nt, slab; };
struct Gemm { const void* A; const void* Bt; int rowB; size_t estride; };

struct TileOrder {
    int nM, nN, nwg, G, c, ntf; const LAS int* mt_e;
    __device__ __forceinline__ void init(int nM_, int nN_, int G_, int c_, const LAS int* mt, int ntf_) { nM = nM_; nN = nN_; nwg = nM * nN; G = G_; c = c_; mt_e = mt; ntf = ntf_; }
    __device__ __forceinline__ void decode(int L, int& pm, int& pn) const {
        int wgid = L; { const int q = nwg / NXCD, r = nwg % NXCD, xcd = wgid % NXCD, off = wgid / NXCD; wgid = (xcd < r ? xcd * (q + 1) : r * (q + 1) + (xcd - r) * q) + off; }
        const int nig = WGM * nN, gid = wgid / nig, fm = gid * WGM, gsz = (nM - fm) < WGM ? (nM - fm) : WGM;
        pm = fm + ((wgid % nig) % gsz); pn = (wgid % nig) / gsz;
    }
    __device__ __forceinline__ bool next(int i, Unit& u) const {
        const long L = (long)i * G + c; if (L >= nwg) return false;
        int pm, pn; decode((int)L, pm, pn); const int e = mt_e ? mt_e[pm] : 0;
        u = Unit{pm, pn, e, 0, ntf, -1}; return true;
    }
};
template <class Sched> struct SubOrder { Sched S; int off, cnt;
    __device__ __forceinline__ bool next(int i, Unit& u) const { return i < cnt && S.next(i + off, u); } };
__device__ __forceinline__ int moe_split(int n_mt, int nN, int G, int ntf) {
    const int R = (n_mt - 128) * nN; if (R <= 0) return 1;
    int S = 1;
#define MS_TRY(cd) if (R * (cd) <= G && ntf % (cd) == 0 && (ntf / (cd)) % 2 == 0 && ntf / (cd) >= 4) S = (cd);
    MS_TRY(2) MS_TRY(4) MS_TRY(7) MS_TRY(14)
#undef MS_TRY
    return S;
}
struct PieceOrder {
    Unit pc; bool has_pc;
    __device__ __forceinline__ void init(int n_mt, int nN, int G, int c, const int* mt, int ntf) {
        const int S = moe_split(n_mt, nN, G, ntf), R = (n_mt - 128) * nN; has_pc = c < R * S;
        const int q = has_pc ? c : 0, ui = q / S, ks = q % S, ntp = ntf / S, pm = 128 + ui / nN;
        pc = Unit{pm, ui % nN, has_pc ? ld_i32_agent(mt + pm) : 0, ks * ntp * 128, ntp, q};
    }
    __device__ __forceinline__ bool next(int i, Unit& u) const { if (i == 0 && has_pc) { u = pc; return true; } return false; }
};

template <bool I8> __device__ __forceinline__ f32x4 cvacc(const f32x4& a) { if constexpr (I8) return __builtin_convertvector(__builtin_bit_cast(i32x4_, a), f32x4); else return a; }
__device__ __forceinline__ float silu_f(float g) { return g * __builtin_amdgcn_rcpf(1.0f + __builtin_amdgcn_exp2f(-1.4426950408889634f * g)); }

struct EpiResid {
    static constexpr bool PERM = false; static constexpr int NST = 32;
    const float* base; float* out; const float* gate; float sc;
    __device__ __forceinline__ void operator()(const f32x4 (&acc)[2][2][4][2], const Unit& u, int wr, int wc, int fr, int fq) const {
        const int row0 = u.pm * BM + wr * 64 + fr, col0 = u.pn * BM + wc * 32 + 4 * fq;
        const float* g = gate + (size_t)(u.pm >> 3) * (6 * DM) + col0;
        f32x4 gv[2][2];
#pragma unroll
        for (int bj = 0; bj < 2; ++bj)
#pragma unroll
            for (int n = 0; n < 2; ++n) gv[bj][n] = *(const f32x4*)(g + bj * HALF + n * 16) * sc;
#pragma unroll
        for (int ai = 0; ai < 2; ++ai)
#pragma unroll
            for (int m = 0; m < 4; ++m) { const size_t off = (size_t)(row0 + ai * HALF + m * 16) * DM + col0;
#pragma unroll
                for (int bj = 0; bj < 2; ++bj)
#pragma unroll
                    for (int n = 0; n < 2; ++n) { const f32x4 bs = *(const f32x4*)(base + off + bj * HALF + n * 16); *(f32x4*)(out + off + bj * HALF + n * 16) = bs + gv[bj][n] * acc[ai][bj][m][n]; }
                asm volatile("" ::: "memory"); }
    }
};
template <bool BASEF32> struct EpiResidBf {
    static constexpr bool PERM = true; static constexpr int NST = 16;
    const void* base; bf16_t* out; const float* gate; float sc;
    __device__ __forceinline__ void operator()(const f32x4 (&acc)[2][2][4][2], const Unit& u, int wr, int wc, int fr, int fq) const {
        const int row0 = u.pm * BM + wr * 64 + fr, col0 = u.pn * BM + wc * 32 + 8 * fq;
        const float* g = gate + (size_t)(u.pm >> 3) * (6 * DM) + col0;
        f32x4 gv[2][2];
#pragma unroll
        for (int bj = 0; bj < 2; ++bj)
#pragma unroll
            for (int n = 0; n < 2; ++n) gv[bj][n] = *(const f32x4*)(g + bj * HALF + n * 4) * sc;
#pragma unroll
        for (int ai = 0; ai < 2; ++ai)
#pragma unroll
            for (int m = 0; m < 4; ++m) { const size_t off = (size_t)(row0 + ai * HALF + m * 16) * DM + col0;
#pragma unroll
                for (int bj = 0; bj < 2; ++bj) { f32x4 b0, b1;
                    if constexpr (BASEF32) { b0 = *(const f32x4*)((const float*)base + off + bj * HALF); b1 = *(const f32x4*)((const float*)base + off + bj * HALF + 4); }
                    else { const u32x4 w = *(const u32x4*)((const bf16_t*)base + off + bj * HALF); b0 = (f32x4){hf_lo(w.x), hf_hi(w.x), hf_lo(w.y), hf_hi(w.y)}; b1 = (f32x4){hf_lo(w.z), hf_hi(w.z), hf_lo(w.w), hf_hi(w.w)}; }
                    const f32x4 o0 = b0 + gv[bj][0] * acc[ai][bj][m][0], o1 = b1 + gv[bj][1] * acc[ai][bj][m][1];
                    u32x4 ow; ow.x = pk_f16(o0[0], o0[1]); ow.y = pk_f16(o0[2], o0[3]); ow.z = pk_f16(o1[0], o1[1]); ow.w = pk_f16(o1[2], o1[3]);
                    *(u32x4*)(out + off + bj * HALF) = ow; }
                asm volatile("" ::: "memory"); }
    }
};
template <bool F8OUT, bool I8 = false, bool OBLK = false> struct EpiSwiglu {
    static constexpr bool PERM = true; static constexpr int NST = 8;
    void* O; int ldc; float isc, osc; const float* rs; float isc_u;
    mutable int cpm = -1; mutable float rrow[2][4];
    __device__ __forceinline__ static f32x2 sw2(f32x2 gi, f32x2 ui, float ea, float c) {
        const f32x2 t = gi * ea; f32x2 e; e.x = __builtin_amdgcn_exp2f(t.x); e.y = __builtin_amdgcn_exp2f(t.y);
        const f32x2 d = e + 1.0f; f32x2 r; r.x = __builtin_amdgcn_rcpf(d.x); r.y = __builtin_amdgcn_rcpf(d.y);
        return ((gi * ui) * c) * r;
    }
    __device__ __forceinline__ void operator()(const f32x4 (&acc)[2][2][4][2], const Unit& u, int wr, int wc, int fr, int fq) const {
        const int row0 = u.pm * BM + wr * 64 + fr, col0 = u.pn * HALF + wc * 32 + 8 * fq;
        if (!I8) { if (cpm < 0) { cpm = 0;
#pragma unroll
            for (int ai = 0; ai < 2; ++ai)
#pragma unroll
                for (int m = 0; m < 4; ++m) rrow[ai][m] = 1.f; } }
        else if (u.pm != cpm) { cpm = u.pm;
#pragma unroll
            for (int ai = 0; ai < 2; ++ai)
#pragma unroll
                for (int m = 0; m < 4; ++m) rrow[ai][m] = rs[row0 + ai * HALF + m * 16];
            asm volatile("" : "+v"(rrow[0][0]), "+v"(rrow[0][1]), "+v"(rrow[0][2]), "+v"(rrow[0][3]), "+v"(rrow[1][0]), "+v"(rrow[1][1]), "+v"(rrow[1][2]), "+v"(rrow[1][3])); }
#pragma unroll
        for (int ai = 0; ai < 2; ++ai)
#pragma unroll
            for (int m = 0; m < 4; ++m) {
                const float sg = rrow[ai][m] * isc, su = rrow[ai][m] * isc_u, ea = -1.4426950408889634f * sg, c = sg * su * (F8OUT ? osc : 1.f);
                const f32x4 g0 = cvacc<I8>(acc[ai][0][m][0]), g1 = cvacc<I8>(acc[ai][0][m][1]), u0 = cvacc<I8>(acc[ai][1][m][0]), u1 = cvacc<I8>(acc[ai][1][m][1]);
                const f32x2 h0 = sw2((f32x2){g0[0], g0[1]}, (f32x2){u0[0], u0[1]}, ea, c), h1 = sw2((f32x2){g0[2], g0[3]}, (f32x2){u0[2], u0[3]}, ea, c),
                            h2 = sw2((f32x2){g1[0], g1[1]}, (f32x2){u1[0], u1[1]}, ea, c), h3 = sw2((f32x2){g1[2], g1[3]}, (f32x2){u1[2], u1[3]}, ea, c);
                if constexpr (F8OUT) { unsigned char* rowp = OBLK ? (unsigned char*)O + (size_t)u.pm * BM * ldc + (size_t)(u.pn * 4 + wc) * 8192 + (wr * 64 + fr + ai * HALF + m * 16) * 32 + 8 * fq
                                                                  : (unsigned char*)O + (size_t)(row0 + ai * HALF + m * 16) * ldc + col0;
                    u32x2 w; w.x = pk4_fp8(h0.x, h0.y, h1.x, h1.y); w.y = pk4_fp8(h2.x, h2.y, h3.x, h3.y); *(u32x2*)rowp = w; }
                else { bf16_t* rowp = (bf16_t*)O + (size_t)(row0 + ai * HALF + m * 16) * ldc + col0;
                    u32x4 w; w.x = cvt_pk_bf16(h0.x, h0.y); w.y = cvt_pk_bf16(h1.x, h1.y); w.z = cvt_pk_bf16(h2.x, h2.y); w.w = cvt_pk_bf16(h3.x, h3.y); *(u32x4*)rowp = w; } }
    }
};
template <bool I8> struct EpiConvIn {
    static constexpr bool PERM = true; static constexpr int NST = 8;
    bf16_t* U; bf16_t* BG; const float* rs; float isc; mutable int cpm = -1; mutable float rrow[2][4];
    __device__ __forceinline__ void operator()(const f32x4 (&acc)[2][2][4][2], const Unit& u, int wr, int wc, int fr, int fq) const {
        const int row0 = u.pm * BM + wr * 64 + fr;
        if (I8 && u.pm != cpm) { cpm = u.pm;
#pragma unroll
            for (int ai = 0; ai < 2; ++ai)
#pragma unroll
                for (int m = 0; m < 4; ++m) rrow[ai][m] = rs[row0 + ai * HALF + m * 16];
            asm volatile("" : "+v"(rrow[0][0]), "+v"(rrow[0][1]), "+v"(rrow[0][2]), "+v"(rrow[0][3]), "+v"(rrow[1][0]), "+v"(rrow[1][1]), "+v"(rrow[1][2]), "+v"(rrow[1][3])); }
        if (u.pn < 16) {
            const int col0 = u.pn * HALF + wc * 32 + 8 * fq;
#pragma unroll
            for (int ai = 0; ai < 2; ++ai)
#pragma unroll
                for (int m = 0; m < 4; ++m) { bf16_t* rowp = U + (size_t)(row0 + ai * HALF + m * 16) * DM + col0;
                    const float rsc = I8 ? rrow[ai][m] * isc : 1.f, rs2 = rsc * rsc;
                    const f32x4 a0 = cvacc<I8>(acc[ai][0][m][0]) * cvacc<I8>(acc[ai][1][m][0]) * rs2, a1 = cvacc<I8>(acc[ai][0][m][1]) * cvacc<I8>(acc[ai][1][m][1]) * rs2;
                    u32x4 w; w.x = cvt_pk_bf16(a0[0], a0[1]); w.y = cvt_pk_bf16(a0[2], a0[3]); w.z = cvt_pk_bf16(a1[0], a1[1]); w.w = cvt_pk_bf16(a1[2], a1[3]);
                    *(u32x4*)rowp = w; }
        } else {
            const int col0 = (u.pn - 16) * BM + wc * 32 + 8 * fq;
#pragma unroll
            for (int ai = 0; ai < 2; ++ai)
#pragma unroll
                for (int m = 0; m < 4; ++m) { bf16_t* rowp = BG + (size_t)(row0 + ai * HALF + m * 16) * DM + col0;
                    const float rsc = I8 ? rrow[ai][m] * isc : 1.f;
#pragma unroll
                    for (int bj = 0; bj < 2; ++bj) { const f32x4 v0 = cvacc<I8>(acc[ai][bj][m][0]) * rsc, v1 = cvacc<I8>(acc[ai][bj][m][1]) * rsc;
                        u32x4 w; w.x = cvt_pk_bf16(v0[0], v0[1]); w.y = cvt_pk_bf16(v0[2], v0[3]); w.z = cvt_pk_bf16(v1[0], v1[1]); w.w = cvt_pk_bf16(v1[2], v1[3]);
                        *(u32x4*)(rowp + bj * HALF) = w; } }
        }
    }
};
template <bool I8 = false> struct EpiBf16T {
    static constexpr bool PERM = true; static constexpr int NST = 16;
    bf16_t* O; int ldc; float sc; const float* rs; mutable int cpm = -1; mutable float rrow[2][4];
    __device__ __forceinline__ void operator()(const f32x4 (&acc)[2][2][4][2], const Unit& u, int wr, int wc, int fr, int fq) const {
        const int row0 = u.pm * BM + wr * 64 + fr, col0 = u.pn * BM + wc * 32 + 8 * fq;
        if (I8 && u.pm != cpm) { cpm = u.pm;
#pragma unroll
            for (int ai = 0; ai < 2; ++ai)
#pragma unroll
                for (int m = 0; m < 4; ++m) rrow[ai][m] = rs[row0 + ai * HALF + m * 16];
            asm volatile("" : "+v"(rrow[0][0]), "+v"(rrow[0][1]), "+v"(rrow[0][2]), "+v"(rrow[0][3]), "+v"(rrow[1][0]), "+v"(rrow[1][1]), "+v"(rrow[1][2]), "+v"(rrow[1][3])); }
#pragma unroll
        for (int ai = 0; ai < 2; ++ai)
#pragma unroll
            for (int m = 0; m < 4; ++m) { bf16_t* rowp = O + (size_t)(row0 + ai * HALF + m * 16) * ldc + col0;
                const float rsc = I8 ? rrow[ai][m] * sc : sc;
#pragma unroll
                for (int bj = 0; bj < 2; ++bj) { const f32x4 v0 = cvacc<I8>(acc[ai][bj][m][0]) * rsc, v1 = cvacc<I8>(acc[ai][bj][m][1]) * rsc;
                    u32x4 w; w.x = cvt_pk_bf16(v0[0], v0[1]); w.y = cvt_pk_bf16(v0[2], v0[3]); w.z = cvt_pk_bf16(v1[0], v1[1]); w.w = cvt_pk_bf16(v1[2], v1[3]);
                    *(u32x4*)(rowp + bj * HALF) = w; } }
    }
};
typedef EpiBf16T<false> EpiBf16;
template <bool I8> struct EpiQKV {
    static constexpr bool PERM = true; static constexpr int NST = 16;
    bf16_t* O; float sc; const float* rs; const float* qg; const float* kg; const float* rope; float* kmean; LAS float* ex;
    mutable int cpm = -1; mutable float rrow[2][4];
    __device__ __forceinline__ void operator()(const f32x4 (&acc)[2][2][4][2], const Unit& u, int wr, int wc, int fr_, int fq_) const {
        int fr = fr_, fq = fq_; asm volatile("" : "+v"(fr), "+v"(fq));
        const int row0 = u.pm * BM + wr * 64 + fr;
        if (I8 && u.pm != cpm) { cpm = u.pm;
#pragma unroll
            for (int ai = 0; ai < 2; ++ai)
#pragma unroll
                for (int m = 0; m < 4; ++m) rrow[ai][m] = rs[row0 + ai * HALF + m * 16];
            asm volatile("" : "+v"(rrow[0][0]), "+v"(rrow[0][1]), "+v"(rrow[0][2]), "+v"(rrow[0][3]), "+v"(rrow[1][0]), "+v"(rrow[1][1]), "+v"(rrow[1][2]), "+v"(rrow[1][3])); }
        if (u.pn >= 16) {
            const int col0 = u.pn * BM + wc * 32 + 8 * fq;
#pragma unroll
            for (int ai = 0; ai < 2; ++ai)
#pragma unroll
                for (int m = 0; m < 4; ++m) { bf16_t* rowp = O + (size_t)(row0 + ai * HALF + m * 16) * 6144 + col0; const float rsc = I8 ? rrow[ai][m] * sc : sc;
#pragma unroll
                    for (int bj = 0; bj < 2; ++bj) { const f32x4 v0 = cvacc<I8>(acc[ai][bj][m][0]) * rsc, v1 = cvacc<I8>(acc[ai][bj][m][1]) * rsc;
                        u32x4 w; w.x = cvt_pk_bf16(v0[0], v0[1]); w.y = cvt_pk_bf16(v0[2], v0[3]); w.z = cvt_pk_bf16(v1[0], v1[1]); w.w = cvt_pk_bf16(v1[2], v1[3]);
                        *(u32x4*)(rowp + bj * HALF) = w; } }
            return;
        }
        const bool isk = u.pn >= 8; const int lane = threadIdx.x & 63;
        const int f0 = 16 * wc + 4 * fq;
        LAS float* P = ex; LAS float* KS = ex + 2048;
#pragma unroll
        for (int ai = 0; ai < 2; ++ai)
#pragma unroll
            for (int m = 0; m < 4; ++m) { const float rsc = I8 ? rrow[ai][m] * sc : sc; const int rl = wr * 64 + fr + ai * HALF + m * 16;
#pragma unroll
                for (int bj = 0; bj < 2; ++bj) { const f32x4 a = cvacc<I8>(acc[ai][bj][m][0]) * rsc, b = cvacc<I8>(acc[ai][bj][m][1]) * rsc;
                    float ss = (a[0] * a[0] + a[1] * a[1]) + (a[2] * a[2] + a[3] * a[3]) + (b[0] * b[0] + b[1] * b[1]) + (b[2] * b[2] + b[3] * b[3]);
                    ss += __shfl_xor(ss, 16); ss += __shfl_xor(ss, 32);
                    if (fq == 0) P[(rl * 2 + bj) * 4 + wc] = ss; } }
        asm volatile("s_waitcnt lgkmcnt(0)" ::: "memory"); __builtin_amdgcn_s_barrier(); asm volatile("" ::: "memory");
        const float* gn = isk ? kg : qg; const f32x4 g0 = *(const f32x4*)(gn + f0), g1 = *(const f32x4*)(gn + 64 + f0);
        f32x4 ks[2][2];
#pragma unroll
        for (int bj = 0; bj < 2; ++bj) { ks[bj][0] = (f32x4){0.f, 0.f, 0.f, 0.f}; ks[bj][1] = (f32x4){0.f, 0.f, 0.f, 0.f}; }
        const int colh = (isk ? DM : 0) + (u.pn & 7) * BM;
#pragma unroll
        for (int ai = 0; ai < 2; ++ai)
#pragma unroll
            for (int m = 0; m < 4; ++m) { const float rsc = I8 ? rrow[ai][m] * sc : sc; const int rl = wr * 64 + fr + ai * HALF + m * 16, row = u.pm * BM + rl, pos = row & (SEQ - 1);
                const f32x4 cs = *(const f32x4*)(rope + pos * 64 + f0), sn = *(const f32x4*)(rope + SEQ * 64 + pos * 64 + f0);
#pragma unroll
                for (int bj = 0; bj < 2; ++bj) { const LAS f32x4* pp = (const LAS f32x4*)(P + (rl * 2 + bj) * 4); const f32x4 p4 = *pp;
                    const float rstd = 1.0f / sqrtf(((p4[0] + p4[1]) + (p4[2] + p4[3])) * (1.f / HD) + NORM_EPS);
                    f32x4 t0 = acc[ai][bj][m][0], t1 = acc[ai][bj][m][1]; asm volatile("" : "+v"(t0), "+v"(t1));
                    const f32x4 y0 = cvacc<I8>(t0) * (rsc * rstd) * g0, y1 = cvacc<I8>(t1) * (rsc * rstd) * g1;
                    const f32x4 o0 = y0 * cs - y1 * sn, o1 = y1 * cs + y0 * sn;
                    ks[bj][0] += o0; ks[bj][1] += o1;
                    asm volatile("" : "+v"(ks[bj][0]), "+v"(ks[bj][1]));
                    bf16_t* rowp = O + (size_t)row * 6144 + colh + bj * HD + f0;
                    u32x2 w0; w0.x = cvt_pk_bf16(o0[0], o0[1]); w0.y = cvt_pk_bf16(o0[2], o0[3]); u32x2 w1; w1.x = cvt_pk_bf16(o1[0], o1[1]); w1.y = cvt_pk_bf16(o1[2], o1[3]);
                    *(u32x2*)rowp = w0; *(u32x2*)(rowp + 64) = w1; }
                asm volatile("" ::: "memory"); }
        if (isk) {
#pragma unroll
            for (int bj = 0; bj < 2; ++bj)
#pragma unroll
                for (int n = 0; n < 2; ++n)
#pragma unroll
                    for (int i = 0; i < 4; ++i) { float v = ks[bj][n][i]; v += __shfl_xor(v, 1); v += __shfl_xor(v, 2); v += __shfl_xor(v, 4); v += __shfl_xor(v, 8);
                        if (fr == 0) KS[(wr * 2 + bj) * HD + 64 * n + f0 + i] = v; }
            asm volatile("s_waitcnt lgkmcnt(0)" ::: "memory"); __builtin_amdgcn_s_barrier(); asm volatile("" ::: "memory");
            int t = threadIdx.x; asm volatile("" : "+v"(t)); if (t < 2 * HD) { const int bj = t >> 7, d = t & 127; const float v = KS[(0 * 2 + bj) * HD + d] + KS[(1 * 2 + bj) * HD + d];
                const int b = u.pm >> 3, blk = u.pm & 7, hh = 2 * (u.pn & 7) + bj; kmean[(((size_t)b * NH + hh) * NBLK + blk) * HD + d] = v * (1.f / MBLK); }
        }
        (void)lane;
    }
};

struct EpiSlab {
    static constexpr bool PERM = true; static constexpr int NST = 32;
    float* slabs;
    __device__ __forceinline__ void operator()(const f32x4 (&acc)[2][2][4][2], const Unit& u, int wr, int wc, int fr, int fq) const {
        float* sl = slabs + (size_t)u.slab * 65536; const int r0 = wr * 64 + fr, c0 = wc * 32 + 8 * fq;
#pragma unroll
        for (int ai = 0; ai < 2; ++ai)
#pragma unroll
            for (int m = 0; m < 4; ++m) { float* rowp = sl + (size_t)(r0 + ai * HALF + m * 16) * 256 + c0;
#pragma unroll
                for (int bj = 0; bj < 2; ++bj) { *(f32x4*)(rowp + bj * HALF) = acc[ai][bj][m][0]; *(f32x4*)(rowp + bj * HALF + 4) = acc[ai][bj][m][1]; } }
    }
};
typedef int i32x8 __attribute__((ext_vector_type(8)));
template <class Epi, class Sched, bool ALIGN_EPI, int MODE = 0, bool ABLK = false>
__device__ __forceinline__ void gemm_phase(LAS unsigned char* lds, const Gemm g, const Sched& S, const Epi& E) {
    constexpr bool F8 = MODE == 1, I8 = MODE == 2;
    const int tid = threadIdx.x, wid = __builtin_amdgcn_readfirstlane(tid >> 6), lane = tid & 63, wr = wid >> 2, wc = wid & 3, fr = lane & 15, fq = lane >> 4;
    const int rowB = g.rowB;
    unsigned voffA[2], voffB[2];
#pragma unroll
    for (int i = 0; i < 2; ++i) { int R, Cb; if constexpr (F8) stage_rc8(tid * 16 + i * 8192, R, Cb); else { stage_rc(tid * 16 + i * 8192, R, Cb); Cb *= 2; } const int Rb = Epi::PERM ? ((R & ~31) + perm32(R & 31)) : R;
        voffA[i] = ABLK ? (unsigned)((Cb >> 5) * 8192 + R * 32 + (Cb & 31)) : (unsigned)(R * rowB + Cb); voffB[i] = (unsigned)((Cb >> 5) * 8192 + Rb * 32 + (Cb & 31)); }
    const size_t kstep = (size_t)128;
    const size_t hstep = (size_t)HALF * rowB;
    const size_t tstep = 2 * hstep;
    const size_t kstepA = ABLK ? (size_t)32768 : kstep, hstepA = ABLK ? (size_t)4096 : hstep, kstepB = 32768, hstepB = 4096;
#define PG8_K0A(u_) (ABLK ? (size_t)(u_).k0b * 256 : (size_t)(u_).k0b)
    const unsigned ldsw = (unsigned)wid * 1024u;
    const int aoff = F8 ? lds_byte8(wr * 64 + fr, fq * 32) : lds_byte(wr * 64 + fr, fq * 8), boff = F8 ? lds_byte8(wc * 32 + fr, fq * 32) : lds_byte(wc * 32 + fr, fq * 8);
    const int aoff1 = F8 ? lds_byte8(wr * 64 + fr, fq * 32 + 16) : aoff + 1024, boff1 = F8 ? lds_byte8(wc * 32 + fr, fq * 32 + 16) : boff + 1024;
#define PG8_SA(b, h) (((b) * 2 + (h)) * HTB)
#define PG8_SB(b, h) ((4 + (b) * 2 + (h)) * HTB)
#define PG8_STAGE(bufoff, gbase, voff) do { _Pragma("unroll") for (int _i = 0; _i < 2; ++_i) \
        __builtin_amdgcn_global_load_lds((const unsigned*)((const char*)(gbase) + (voff)[_i]), (LAS unsigned*)(lds + (bufoff) + ldsw + _i * 8192), 16, 0, 0); } while (0)
#define PG8_LDA(dst, b, h) do { _Pragma("unroll") for (int m = 0; m < 4; ++m) { const i32x4_ l_ = *(const LAS i32x4_*)(lds + PG8_SA(b, h) + aoff + m * 2048), h_ = *(const LAS i32x4_*)(lds + PG8_SA(b, h) + aoff1 + m * 2048); dst[m] = __builtin_shufflevector(l_, h_, 0, 1, 2, 3, 4, 5, 6, 7); } } while (0)
#define PG8_LDB(dst, b, h) do { _Pragma("unroll") for (int n = 0; n < 2; ++n) { const i32x4_ l_ = *(const LAS i32x4_*)(lds + PG8_SB(b, h) + boff + n * 2048), h_ = *(const LAS i32x4_*)(lds + PG8_SB(b, h) + boff1 + n * 2048); dst[n] = __builtin_shufflevector(l_, h_, 0, 1, 2, 3, 4, 5, 6, 7); } } while (0)
#define PG8_BFLO(x) __builtin_bit_cast(bf16x8, __builtin_shufflevector(x, x, 0, 1, 2, 3))
#define PG8_BFHI(x) __builtin_bit_cast(bf16x8, __builtin_shufflevector(x, x, 4, 5, 6, 7))
#define PG8_MMA(ai, bj, At, Bt) do { __builtin_amdgcn_s_setprio(1); _Pragma("unroll") for (int m = 0; m < 4; ++m) _Pragma("unroll") for (int n = 0; n < 2; ++n) { if constexpr (F8) \
        asm volatile("v_mfma_scale_f32_16x16x128_f8f6f4 %0, %1, %2, %0, %3, %3 op_sel_hi:[0,0,0]" : "+v"(acc[ai][bj][m][n]) : "v"(Bt[n]), "v"(At[m]), "v"(one_scale)); \
        else if constexpr (I8) { i32x4_ c_ = __builtin_bit_cast(i32x4_, acc[ai][bj][m][n]); c_ = __builtin_amdgcn_mfma_i32_16x16x64_i8(__builtin_shufflevector(Bt[n], Bt[n], 0, 1, 2, 3), __builtin_shufflevector(At[m], At[m], 0, 1, 2, 3), c_, 0, 0, 0); \
               c_ = __builtin_amdgcn_mfma_i32_16x16x64_i8(__builtin_shufflevector(Bt[n], Bt[n], 4, 5, 6, 7), __builtin_shufflevector(At[m], At[m], 4, 5, 6, 7), c_, 0, 0, 0); acc[ai][bj][m][n] = __builtin_bit_cast(f32x4, c_); } \
        else { acc[ai][bj][m][n] = __builtin_amdgcn_mfma_f32_16x16x32_bf16(PG8_BFLO(Bt[n]), PG8_BFLO(At[m]), acc[ai][bj][m][n], 0, 0, 0); \
               acc[ai][bj][m][n] = __builtin_amdgcn_mfma_f32_16x16x32_bf16(PG8_BFHI(Bt[n]), PG8_BFHI(At[m]), acc[ai][bj][m][n], 0, 0, 0); } } __builtin_amdgcn_s_setprio(0); } while (0)
#define PG8_WAIT_V(n) asm volatile("s_waitcnt vmcnt(" #n ")" ::: "memory")
#define PG8_WAIT_L(n) asm volatile("s_waitcnt lgkmcnt(" #n ")" ::: "memory")
#define PG8_BAR __builtin_amdgcn_s_barrier()
#define PG8_SCHED __builtin_amdgcn_sched_barrier(0)
    Unit cur, nxt; int ui = 0;
    if (!S.next(0, cur)) return;
    f32x4 acc[2][2][4][2];
#pragma unroll
    for (int a = 0; a < 2; ++a)
#pragma unroll
        for (int b = 0; b < 2; ++b)
#pragma unroll
            for (int m = 0; m < 4; ++m)
#pragma unroll
                for (int n = 0; n < 2; ++n) acc[a][b][m][n] = (f32x4){0.f, 0.f, 0.f, 0.f};
    const int one_scale = 0x7f7f7f7f;
    i32x8 At[4], B0[2], B1[2];
    const char* cA = (const char*)g.A + (size_t)cur.pm * tstep + PG8_K0A(cur); const char* cB = (const char*)g.Bt + (size_t)cur.e * g.estride + (size_t)cur.pn * tstep + (size_t)cur.k0b * 256;
    PG8_STAGE(PG8_SB(0, 0), cB, voffB); PG8_STAGE(PG8_SB(0, 1), cB + hstepB, voffB); PG8_STAGE(PG8_SA(0, 0), cA, voffA); PG8_STAGE(PG8_SA(0, 1), cA + hstepA, voffA);
    if (wr == 1) PG8_BAR;
    PG8_WAIT_V(2); PG8_BAR;
    PG8_STAGE(PG8_SB(1, 0), cB + kstepB, voffB); PG8_STAGE(PG8_SA(1, 0), cA + kstepA, voffA); PG8_STAGE(PG8_SB(1, 1), cB + hstepB + kstepB, voffB);
    PG8_WAIT_V(6); PG8_BAR;
    for (;;) {
        const bool has_next = S.next(ui + 1, nxt);
        const char* nA = has_next ? (const char*)g.A + (size_t)nxt.pm * tstep + PG8_K0A(nxt) : cA; const char* nB = has_next ? (const char*)g.Bt + (size_t)nxt.e * g.estride + (size_t)nxt.pn * tstep + (size_t)nxt.k0b * 256 : cB;
        const int ntu = cur.nt;
#define PG8_WAIT_VI(n) asm volatile("s_waitcnt vmcnt(%0)" :: "i"(n) : "memory")
#define PG8_KPAIR(t, WA) do { \
            const bool last = ((t) == ntu - 2); \
            const char* a1 = cA + (size_t)((t) + 1) * kstepA; \
            const char* a2 = last ? nA : cA + (size_t)((t) + 2) * kstepA; const char* b2 = last ? nB : cB + (size_t)((t) + 2) * kstepB; \
            const char* a3 = a2 + kstepA; const char* b3 = b2 + kstepB; \
            PG8_LDB(B0, 0, 0); PG8_LDB(B1, 0, 1); PG8_SCHED; PG8_LDA(At, 0, 0); PG8_STAGE(PG8_SA(1, 1), a1 + hstepA, voffA); \
            if (WA) PG8_WAIT_VI(8 + Epi::NST); else PG8_WAIT_V(8); PG8_WAIT_L(0); PG8_BAR; PG8_MMA(0, 0, At, B0); PG8_MMA(0, 1, At, B1); PG8_BAR; PG8_SCHED; \
            PG8_LDA(At, 0, 1); PG8_STAGE(PG8_SB(0, 0), b2, voffB); PG8_STAGE(PG8_SB(0, 1), b2 + hstepB, voffB); PG8_STAGE(PG8_SA(0, 0), a2, voffA); \
            if (WA) PG8_WAIT_VI(8 + Epi::NST); else PG8_WAIT_V(8); PG8_WAIT_L(0); PG8_BAR; PG8_MMA(1, 0, At, B0); PG8_MMA(1, 1, At, B1); PG8_BAR; PG8_SCHED; \
            PG8_LDB(B0, 1, 0); PG8_LDB(B1, 1, 1); PG8_SCHED; PG8_LDA(At, 1, 0); PG8_STAGE(PG8_SA(0, 1), a2 + hstepA, voffA); \
            PG8_WAIT_V(8); PG8_WAIT_L(0); PG8_BAR; PG8_MMA(0, 0, At, B0); PG8_MMA(0, 1, At, B1); PG8_BAR; PG8_SCHED; \
            PG8_LDA(At, 1, 1); PG8_STAGE(PG8_SB(1, 0), b3, voffB); PG8_STAGE(PG8_SB(1, 1), b3 + hstepB, voffB); PG8_STAGE(PG8_SA(1, 0), a3, voffA); \
            PG8_WAIT_V(8); PG8_WAIT_L(0); PG8_BAR; PG8_MMA(1, 0, At, B0); PG8_MMA(1, 1, At, B1); PG8_BAR; PG8_SCHED; } while (0)
        int trel = ui > 0 ? 0 : -2; asm volatile("" : "+s"(trel));
        for (int t = 0; t < ntu; t += 2) { const bool relaxed = (t == trel); PG8_KPAIR(t, relaxed); }
#undef PG8_KPAIR
#undef PG8_WAIT_VI
        if constexpr (F8) asm volatile("s_nop 15\n\ts_nop 15" ::: "memory");
        if constexpr (ALIGN_EPI) { if (wr == 0) PG8_BAR; }
        E(acc, cur, wr, wc, fr, fq);
        if (!has_next) break;
#pragma unroll
        for (int a = 0; a < 2; ++a)
#pragma unroll
            for (int b = 0; b < 2; ++b)
#pragma unroll
                for (int m = 0; m < 4; ++m)
#pragma unroll
                    for (int n = 0; n < 2; ++n) acc[a][b][m][n] = (f32x4){0.f, 0.f, 0.f, 0.f};
        cur = nxt; cA = nA; cB = nB; ++ui;
        if constexpr (ALIGN_EPI) { if (wr == 1) PG8_BAR; }
    }
    PG8_WAIT_V(0);
    if constexpr (!ALIGN_EPI) { if (wr == 0) PG8_BAR; }
    PG8_BAR;
#undef PG8_K0A
#undef PG8_SA
#undef PG8_SB
#undef PG8_STAGE
#undef PG8_LDA
#undef PG8_LDB
#undef PG8_MMA
#undef PG8_BFLO
#undef PG8_BFHI
#undef PG8_WAIT_V
#undef PG8_WAIT_L
#undef PG8_BAR
#undef PG8_SCHED
}
}

namespace moba {
constexpr int D = 128, NW = 8, QBLK = 32, KVBLK = 64, QB = NW * QBLK;
constexpr int LDQ = 6144, LDO = 2048;
constexpr float SCALE = 0.08838834764831845f, THR = 8.f;
constexpr int SHM_V = KVBLK * D * 2, SHM_K = KVBLK * D * 2;
constexpr int UNI_OFF = 2 * SHM_V + 2 * SHM_K + NW * 64 * 4;
constexpr int NQREG = 4;
constexpr int Q_OFF = UNI_OFF + 64;
constexpr int LDS_BYTES = Q_OFF + NW * 8192;
#define KSWZ(row, colB) ((row) * 256 + ((colB) ^ (((row) & 7) << 4)))
#define SBAR() __builtin_amdgcn_sched_barrier(0)
__device__ __forceinline__ int v_st(int k, int c) { const int kk = (k & ~0xC) | ((k & 4) << 1) | ((k & 8) >> 1); return ((kk >> 3) * 4 + (c >> 5)) * 512 + ((kk & 7) * 32 + (c & 31)) * 2; }
__device__ __forceinline__ int v_rd_base(int lane) { return ((lane & 3) << 3) | (((lane >> 2) & 3) << 6) | (((lane >> 4) & 1) << 5) | (((lane >> 5) & 1) << 8); }
constexpr int v_rd_off(int d0, int ks, int half) { return d0 * 512 + ks * 4096 + half * 2048; }
__device__ __forceinline__ int crow(int r, int hi) { return (r & 3) + 8 * (r >> 2) + 4 * hi; }
__device__ __forceinline__ bf16x8 load8(const bf16_t* p) { return *reinterpret_cast<const bf16x8*>(p); }
__device__ __forceinline__ void mask_causal(f32x16& p0, f32x16& p1, int dq) {
    const float NEG = -__builtin_inff();
#pragma unroll
    for (int r = 0; r < 16; ++r) { const int c = (r & 3) + 8 * (r >> 2); if (dq - c < 0) p0[r] = NEG; if (dq - c - 32 < 0) p1[r] = NEG; }
}
__device__ __forceinline__ void mask_all(f32x16& p0, f32x16& p1, bool keep) {
    const float NEG = -__builtin_inff();
#pragma unroll
    for (int r = 0; r < 16; ++r) { p0[r] = keep ? p0[r] : NEG; p1[r] = keep ? p1[r] : NEG; }
}
__device__ __forceinline__ void partialSM(f32x16& p0, f32x16& p1, float& m_reg, float& mn, float& alpha) {
    float pmax = p0[0]; for (int r = 1; r < 16; ++r) pmax = fmaxf(pmax, p0[r]); for (int r = 0; r < 16; ++r) pmax = fmaxf(pmax, p1[r]);
    { auto rr = __builtin_amdgcn_permlane32_swap(__float_as_uint(pmax), __float_as_uint(pmax), false, false);
      pmax = fmaxf(__uint_as_float(rr[0]), __uint_as_float(rr[1])); }
    constexpr float C2 = 1.4426950408889634f * SCALE;
    if (__builtin_expect(__all((pmax - m_reg) * SCALE <= THR), 1)) { mn = m_reg; alpha = 1.f; }
    else { mn = fmaxf(m_reg, pmax); alpha = __builtin_amdgcn_exp2f((m_reg - mn) * C2); m_reg = mn; }
    const float mnL = -mn * C2;
    for (int r = 0; r < 16; ++r) p0[r] = fmaf(p0[r], C2, mnL); for (int r = 0; r < 16; ++r) p1[r] = fmaf(p1[r], C2, mnL);
    for (int r = 0; r < 16; ++r) p0[r] = __builtin_amdgcn_exp2f(p0[r]);
}
__device__ __forceinline__ void finishSM(f32x16& p0, f32x16& p1, float alpha, float& l_reg, bf16x8& pa0, bf16x8& pa1, bf16x8& pa2, bf16x8& pa3) {
    for (int r = 0; r < 16; ++r) p1[r] = __builtin_amdgcn_exp2f(p1[r]);
    float ps = 0; for (int r = 0; r < 16; ++r) ps += p0[r]; for (int r = 0; r < 16; ++r) ps += p1[r];
    { auto rr = __builtin_amdgcn_permlane32_swap(__float_as_uint(ps), __float_as_uint(ps), false, false);
      ps = __uint_as_float(rr[0]) + __uint_as_float(rr[1]); }
    l_reg = l_reg * alpha + ps;
#define PK4(P, B_, OUT) do { unsigned a0 = cvt_pk_bf16(P[B_+0], P[B_+1]), a1 = cvt_pk_bf16(P[B_+2], P[B_+3]);                          \
        unsigned b0 = cvt_pk_bf16(P[B_+4], P[B_+5]), b1 = cvt_pk_bf16(P[B_+6], P[B_+7]);                                             \
        auto r0 = __builtin_amdgcn_permlane32_swap(a0, b0, false, false); auto r1 = __builtin_amdgcn_permlane32_swap(a1, b1, false, false); \
        u32x4 w = {r0[0], r1[0], r0[1], r1[1]}; OUT = *reinterpret_cast<bf16x8*>(&w); } while (0)
    PK4(p0, 0, pa0); PK4(p0, 8, pa1); PK4(p1, 0, pa2); PK4(p1, 8, pa3);
#undef PK4
}
template <int KB>
__device__ __forceinline__ void qkt(f32x16& p0, f32x16& p1, const LAS char* K_lds, int r32, int hi, const LAS char* qw, const bf16x8 (&qreg)[NQREG], bool act) {
    if (!act) { const float NEG = -__builtin_inff();
#pragma unroll
        for (int r = 0; r < 16; ++r) { p0[r] = NEG; p1[r] = NEG; } return; }
    p0 = f32x16{}; p1 = f32x16{};
    const LAS char* kb[4];
#pragma unroll
    for (int dd = 0; dd < 4; ++dd) kb[dd] = K_lds + KB * SHM_K + KSWZ(r32, (dd * 16 + hi * 8) * 2);
#pragma unroll
    for (int d0 = 0; d0 < 8; ++d0) { const LAS char* a = kb[d0 & 3] + (d0 >> 2) * 128;
        bf16x8 b0 = *(const LAS bf16x8*)(a);
        bf16x8 b1 = *(const LAS bf16x8*)(a + 32 * 256);
        const bf16x8 q = d0 < NQREG ? qreg[d0 < NQREG ? d0 : 0] : *(const LAS bf16x8*)(qw + d0 * 1024);
        p0 = __builtin_amdgcn_mfma_f32_32x32x16_bf16(b0, q, p0, 0, 0, 0);
        p1 = __builtin_amdgcn_mfma_f32_32x32x16_bf16(b1, q, p1, 0, 0, 0); }
}
template <int VB>
__device__ __forceinline__ void pv_tile(f32x16* o, int vb0, bf16x8 pa0, bf16x8 pa1, bf16x8 pa2, bf16x8 pa3, bool act) {
    if (!act) return;
#define TRRD(dst, off) asm volatile("ds_read_b64_tr_b16 %0, %1 offset:%2" : "=&v"(dst) : "v"(vb0), "i"(off) : "memory")
#define PV_D0(d0) do { s16x4 l0, l1, l2, l3, h0, h1, h2, h3; constexpr int b_ = VB * SHM_V + v_rd_off(d0, 0, 0); \
        TRRD(l0, b_); TRRD(h0, b_ + 2048); TRRD(l1, b_ + 4096); TRRD(h1, b_ + 6144); TRRD(l2, b_ + 8192); TRRD(h2, b_ + 10240); TRRD(l3, b_ + 12288); TRRD(h3, b_ + 14336); \
        asm volatile("s_waitcnt lgkmcnt(0)" ::: "memory"); SBAR();   \
        o[d0] = __builtin_amdgcn_mfma_f32_32x32x16_bf16(pa0, (bf16x8){l0[0], l0[1], l0[2], l0[3], h0[0], h0[1], h0[2], h0[3]}, o[d0], 0, 0, 0);   \
        o[d0] = __builtin_amdgcn_mfma_f32_32x32x16_bf16(pa1, (bf16x8){l1[0], l1[1], l1[2], l1[3], h1[0], h1[1], h1[2], h1[3]}, o[d0], 0, 0, 0);   \
        o[d0] = __builtin_amdgcn_mfma_f32_32x32x16_bf16(pa2, (bf16x8){l2[0], l2[1], l2[2], l2[3], h2[0], h2[1], h2[2], h2[3]}, o[d0], 0, 0, 0);   \
        o[d0] = __builtin_amdgcn_mfma_f32_32x32x16_bf16(pa3, (bf16x8){l3[0], l3[1], l3[2], l3[3], h3[0], h3[1], h3[2], h3[3]}, o[d0], 0, 0, 0); } while (0)
    PV_D0(0); PV_D0(1); PV_D0(2); PV_D0(3);
#undef PV_D0
#undef TRRD
}
struct BlockRef { const bf16_t* Q; const bf16_t* K; const bf16_t* V; unsigned char* O; int P0; const float* km; };
struct Seam { bf16x8 st_v0, st_v1, st_k0, st_k1; };
#define ROW(p, k0, rr) ((p) + (size_t)((k0) + (rr)) * LDQ + sc)
#define VMWN(n) asm volatile("s_waitcnt vmcnt(%0)" :: "i"(n) : "memory")
#define SLOAD_H(Kp, Vp, k0) do { S.st_v0 = load8(ROW(Vp, k0, sr)); S.st_v1 = load8(ROW(Vp, k0, 32 + sr));              \
                         S.st_k0 = load8(ROW(Kp, k0, sr)); S.st_k1 = load8(ROW(Kp, k0, 32 + sr)); } while (0)
#define QDMA(Qp) do { _Pragma("unroll") for (int d0 = 0; d0 < 8; ++d0) __builtin_amdgcn_global_load_lds((const unsigned*)((Qp) + (size_t)(wid * QBLK + r32) * LDQ + d0 * 16 + hi * 8), (LAS unsigned*)(lds + Q_OFF + wid * 8192 + d0 * 1024), 16, 0, 0); } while (0)
#define SWRITE_HK(bf) do { *(LAS bf16x8*)(K_lds + (bf) * SHM_K + kws) = S.st_k0; *(LAS bf16x8*)(K_lds + (bf) * SHM_K + kws + 32 * 256) = S.st_k1; } while (0)
#define SWRITE_HV(bf) do { *(LAS bf16x8*)(V_lds + (bf) * SHM_V + vst0) = S.st_v0; *(LAS bf16x8*)(V_lds + (bf) * SHM_V + vst1) = S.st_v1; } while (0)
#define SWRITE_H(bf) do { SWRITE_HV(bf); SWRITE_HK(bf); } while (0)
__device__ __forceinline__ void moba_prime(const BlockRef& cur, LAS char* lds, Seam& S) {
    const int tid = threadIdx.x, wid = __builtin_amdgcn_readfirstlane(tid >> 6), lane = tid & 63, r32 = lane & 31, hi = lane >> 5;
    const int sr = tid >> 4, sc = (tid & 15) * 8, kws = KSWZ(sr, sc * 2); LAS char* K_lds = lds + 2 * SHM_V;
    const int kb0 = cur.P0;
    QDMA(cur.Q);
    SLOAD_H(cur.K, cur.V, kb0); VM_WAIT(); SWRITE_HK(0);
    __syncthreads();
}
__device__ __forceinline__ void moba_block(const BlockRef& cur, const BlockRef& nxt, LAS char* lds, Seam& S) {
    const int tid = threadIdx.x, wid = __builtin_amdgcn_readfirstlane(tid >> 6), lane = tid & 63, r32 = lane & 31, hi = lane >> 5;
    const int own = cur.P0 >> 8;
    const int kbn = nxt.P0;
    const int qlo = cur.P0 + wid * QBLK, qm = qlo + r32 - 4 * hi;
    LAS char* V_lds = lds; LAS char* K_lds = lds + 2 * SHM_V;
    LAS float* ws = (LAS float*)(lds + 2 * SHM_V + 2 * SHM_K) + wid * 64; LAS float* li_l = ws; LAS float* al_l = ws + 32;
    LAS unsigned* uni = (LAS unsigned*)(lds + UNI_OFF);
    float m_reg = -1e30f, l_reg = 0; f32x16 o[4] = {};
    const int sr = tid >> 4, sc = (tid & 15) * 8, vst0 = v_st(sr, sc), vst1 = v_st(32 + sr, sc), kws = KSWZ(sr, sc * 2);
    const int vb0 = (int)(unsigned)(uintptr_t)V_lds + v_rd_base(lane);
    const bf16_t* Kh = cur.K; const bf16_t* Vh = cur.V;
    LAS char* qw = lds + Q_OFF + wid * 8192 + lane * 16;
    SWRITE_HV(0); SBAR();
    SLOAD_H(Kh, Vh, cur.P0 + KVBLK);
    VMWN(4); SBAR();
    bf16x8 qreg[NQREG];
#pragma unroll
    for (int d0 = 0; d0 < NQREG; ++d0) qreg[d0] = *(const LAS bf16x8*)(qw + d0 * 1024);
    unsigned selbits = 0u;
    if (own > 0) {
        if (own <= TOPK) selbits = (1u << own) - 1u;
        else {
            float g[7];
#pragma unroll
            for (int j = 0; j < 7; ++j) { g[j] = -__builtin_inff();
                if (j < own) { float a = 0.f; const float* kmj = cur.km + j * D + hi * 8;
#pragma unroll
                    for (int d0 = 0; d0 < 8; ++d0) { const f32x4 k0 = *(const f32x4*)(kmj + d0 * 16), k1 = *(const f32x4*)(kmj + d0 * 16 + 4); const u32x4 qv = *(const LAS u32x4*)(qw + d0 * 1024);
                        a = fmaf(bf_lo(qv.x), k0[0], a); a = fmaf(bf_hi(qv.x), k0[1], a); a = fmaf(bf_lo(qv.y), k0[2], a); a = fmaf(bf_hi(qv.y), k0[3], a);
                        a = fmaf(bf_lo(qv.z), k1[0], a); a = fmaf(bf_hi(qv.z), k1[1], a); a = fmaf(bf_lo(qv.w), k1[2], a); a = fmaf(bf_hi(qv.w), k1[3], a); }
                    auto rr = __builtin_amdgcn_permlane32_swap(__float_as_uint(a), __float_as_uint(a), false, false);
                    g[j] = __uint_as_float(rr[0]) + __uint_as_float(rr[1]); } }
#pragma unroll
            for (int k = 0; k < TOPK; ++k) { float best = -__builtin_inff(); int bi = 0;
#pragma unroll
                for (int j = 6; j >= 0; --j) { const bool ok = (j < own) && !((selbits >> j) & 1u) && (g[j] >= best); best = ok ? g[j] : best; bi = ok ? j : bi; }
                selbits |= 1u << bi; }
        }
    }
    unsigned wuni = 0u;
#pragma unroll
    for (int j = 0; j < 7; ++j) wuni |= (__ballot((selbits >> j) & 1u) != 0ull) ? (1u << j) : 0u;
    if (lane == 0) uni[wid] = wuni;
#define RESC(a) do { if (__any((a) < 1.f)) { if (hi == 0) al_l[r32] = (a); asm volatile("s_waitcnt lgkmcnt(0)" ::: "memory");              \
                     for (int d_ = 0; d_ < 4; ++d_) for (int r = 0; r < 16; ++r) o[d_][r] *= al_l[crow(r, hi)]; } } while (0)
    unsigned blist = (unsigned)own; int NT = 4;
#define BLK(t) ((int)((blist >> (4 * ((t) >> 2))) & 15u))
#define KBASE(t) (BLK(t) * MBLK + ((t) & 3) * KVBLK)
#define ACT(t) (BLK(t) == own ? (KBASE(t) <= qlo + QBLK - 1) : (((wuni >> BLK(t)) & 1u) != 0u))
#define MASKT(P0_, P1_, t) do { const int kb_ = KBASE(t); if (ACT(t)) { if (BLK(t) == own) { if (kb_ + KVBLK - 1 > qlo) mask_causal(P0_, P1_, qm - kb_); } \
                                                                          else mask_all(P0_, P1_, ((selbits >> BLK(t)) & 1u) != 0u); } } while (0)
    constexpr int NQL = 8;
#define SEAM_K0() do { VMWN(NQL); SWRITE_HK(0); SBAR(); } while (0)
    f32x16 pA0, pA1, pB0, pB1; float mnA, mnB, alA, alB; bf16x8 pa0, pa1, pa2, pa3;
    SBAR(); qkt<0>(pA0, pA1, K_lds, r32, hi, qw, qreg, ACT(0));
    MASKT(pA0, pA1, 0); partialSM(pA0, pA1, m_reg, mnA, alA);
    VM_WAIT(); SWRITE_H(1);
    __syncthreads();
    {
        unsigned bu = 0u;
#pragma unroll
        for (int w = 0; w < NW; ++w) bu |= uni[w];
        bu = (unsigned)__builtin_amdgcn_readfirstlane((int)bu);
        int ne = 1;
        for (int j = 0; j < 7; ++j) if ((bu >> j) & 1u) { blist |= (unsigned)j << (4 * ne); ++ne; }
        NT = 4 * ne;
    }
#define HALF_STEP(PX0, PX1, mnX, alX, PY0, PY1, alY, t, KB, VB, SB) do {                                                      \
        SBAR(); qkt<KB>(PX0, PX1, K_lds, r32, hi, qw, qreg, ACT(t));                                             \
        finishSM(PY0, PY1, alY, l_reg, pa0, pa1, pa2, pa3); SBAR();                                                           \
        if ((t) + 1 < NT) { SLOAD_H(Kh, Vh, KBASE((t) + 1)); SBAR(); }                                               \
        pv_tile<VB>(o, vb0, pa0, pa1, pa2, pa3, ACT((t) - 1)); MASKT(PX0, PX1, (t)); partialSM(PX0, PX1, m_reg, mnX, alX);                                        \
        __syncthreads();                                                                                                      \
        if ((t) + 1 < NT) { VM_WAIT(); SWRITE_H(SB); }                                                                          \
        RESC(alX); __syncthreads(); } while (0)
    for (int t = 1; t + 1 < NT; t += 2) {
        HALF_STEP(pB0, pB1, mnB, alB, pA0, pA1, alA, t, 1, 0, 0);
        HALF_STEP(pA0, pA1, mnA, alA, pB0, pB1, alB, t + 1, 0, 1, 1);
    }
    SBAR(); qkt<1>(pB0, pB1, K_lds, r32, hi, qw, qreg, ACT(NT - 1)); SBAR();
    SLOAD_H(nxt.K, nxt.V, kbn); SBAR();
    QDMA(nxt.Q);
    SBAR();
    finishSM(pA0, pA1, alA, l_reg, pa0, pa1, pa2, pa3); SBAR();
    pv_tile<0>(o, vb0, pa0, pa1, pa2, pa3, ACT(NT - 2));
    MASKT(pB0, pB1, NT - 1); partialSM(pB0, pB1, m_reg, mnB, alB); __syncthreads(); RESC(alB);
    finishSM(pB0, pB1, alB, l_reg, pa0, pa1, pa2, pa3); SBAR(); pv_tile<1>(o, vb0, pa0, pa1, pa2, pa3, ACT(NT - 1));
    SBAR(); SEAM_K0();
    if (hi == 0) li_l[r32] = l_reg; asm volatile("s_waitcnt lgkmcnt(0)" ::: "memory");
    float rli[16];
#pragma unroll
    for (int r = 0; r < 16; ++r) rli[r] = __builtin_amdgcn_rcpf(li_l[crow(r, hi)]);
    constexpr int OES = F8_AOUT ? 1 : 2;
    unsigned char* Ow = cur.O + (size_t)(wid * QBLK) * LDO * OES;
#pragma unroll
    for (int r = 0; r < 16; ++r) { const int orow = crow(r, hi);
#pragma unroll
        for (int d0 = 0; d0 < 4; ++d0) { const float v = o[d0][r] * rli[r];
            if constexpr (F8_AOUT) {
                const int vi = __builtin_bit_cast(int, v * O_SCALE);
                const float v1 = __builtin_bit_cast(float, __builtin_amdgcn_mov_dpp(vi, 0x55, 0xF, 0xF, true)), v2 = __builtin_bit_cast(float, __builtin_amdgcn_mov_dpp(vi, 0xAA, 0xF, 0xF, true)), v3 = __builtin_bit_cast(float, __builtin_amdgcn_mov_dpp(vi, 0xFF, 0xF, 0xF, true));
                if ((r32 & 3) == 0) *(unsigned*)(Ow + (size_t)orow * LDO + d0 * 32 + r32) = pk4_fp8(v * O_SCALE, v1, v2, v3);
            } else {
            const float vn = __builtin_bit_cast(float, __builtin_amdgcn_mov_dpp(__builtin_bit_cast(int, v), 0xB1, 0xF, 0xF, true));
            if ((r32 & 1) == 0) *(unsigned*)(Ow + ((size_t)orow * LDO + d0 * 32 + r32) * 2) = cvt_pk_bf16(v, vn); } } }
    __syncthreads();
#undef RESC
#undef BLK
#undef KBASE
#undef ACT
#undef MASKT
#undef SEAM_K0
#undef HALF_STEP
}
#undef ROW
#undef VMWN
#undef SLOAD_H
#undef SWRITE_HK
#undef QDMA
#undef SWRITE_HV
#undef SWRITE_H
#undef SBAR
#undef KSWZ
}
static_assert(moba::LDS_BYTES <= PHASE_LDS, "attention LDS");

#define XB_TMO      128
#define XB_XCNT(j)  (256  + 64 * (j))
#define XB_XSUB(j)  (1280 + 64 * (j))
#define XB_XGEN(j)  (2304 + 64 * (j))
#define XB_TOP      3328
#define XB_TOPGEN   3392
#define XCD_BAR_WORDS 3456
#define XB_SPIN_CAP (1u << 22)
__device__ __forceinline__ unsigned xb_ld(unsigned* p)              { return __hip_atomic_load(p, __ATOMIC_RELAXED, __HIP_MEMORY_SCOPE_AGENT); }
__device__ __forceinline__ unsigned xb_add(unsigned* p, unsigned v) { return __hip_atomic_fetch_add(p, v, __ATOMIC_RELAXED, __HIP_MEMORY_SCOPE_AGENT); }
__device__ __forceinline__ unsigned xb_xcc_id() { return (unsigned)__builtin_amdgcn_s_getreg((3 << 11) | 20) & 0xFu; }
#define XB_SPIN(cond, bar) do { unsigned _sp = 0; while (cond) { __builtin_amdgcn_s_sleep(1); \
    if ((++_sp & 255u) == 0u) { if (xb_ld(&(bar)[XB_TMO])) break; if (_sp > XB_SPIN_CAP) { atomicAdd(&(bar)[XB_TMO], 1u); break; } } } } while (0)
struct XcdBarrier { unsigned* bar; unsigned x; volatile LAS unsigned* st; };
__device__ __forceinline__ XcdBarrier xcd_barrier_post(unsigned* bar, volatile LAS unsigned* st) {
    XcdBarrier b; b.bar = bar; b.x = xb_xcc_id(); b.st = st;
    if (threadIdx.x == 0) (void)xb_add(&bar[XB_XCNT(b.x)], 1u);
    return b;
}
__device__ __forceinline__ void xcd_barrier_complete(unsigned* bar, unsigned x, unsigned& nloc, unsigned& nx) {
    const unsigned G = gridDim.x * gridDim.y * gridDim.z;
    unsigned sum, cnt, mine, sp = 0u;
    for (;;) {
        sum = 0u; cnt = 0u; mine = 0u;
#pragma unroll
        for (unsigned j = 0; j < 16; ++j) { const unsigned c = xb_ld(&bar[XB_XCNT(j)]); sum += c; cnt += (c > 0u) ? 1u : 0u; mine = (j == x) ? c : mine; }
        if (sum == G) break;
        __builtin_amdgcn_s_sleep(1);
        if ((++sp & 255u) == 0u) { if (xb_ld(&bar[XB_TMO])) break; if (sp > XB_SPIN_CAP) { atomicAdd(&bar[XB_TMO], 1u); break; } }
    }
    nloc = mine > 0u ? mine : 1u; nx = cnt > 0u ? cnt : 1u;
}
__device__ __forceinline__ void xcd_barrier(const XcdBarrier& b) {
    asm volatile("s_waitcnt vmcnt(0)" ::: "memory");
    __syncthreads();
    if (threadIdx.x == 0) {
        unsigned* bar = b.bar;
        __builtin_amdgcn_s_waitcnt(0);
        unsigned nloc = b.st[0], nx = b.st[1];
        if (nloc == 0u) { xcd_barrier_complete(bar, b.x, nloc, nx); b.st[0] = nloc; b.st[1] = nx; }
        const unsigned old = xb_add(&bar[XB_XSUB(b.x)], 1u);
        const unsigned gen = old / nloc;
        if (old + 1u == (gen + 1u) * nloc) {
            __builtin_amdgcn_fence(__ATOMIC_RELEASE, "agent");
            asm volatile("s_waitcnt vmcnt(0)" ::: "memory");
            const unsigned og = xb_add(&bar[XB_TOP], 1u);
            const unsigned tg = og / nx;
            if (og + 1u == (tg + 1u) * nx) xb_add(&bar[XB_TOPGEN], 1u);
            else XB_SPIN(xb_ld(&bar[XB_TOPGEN]) == tg, bar);
            __builtin_amdgcn_fence(__ATOMIC_ACQUIRE, "agent");
            xb_add(&bar[XB_XGEN(b.x)], 1u);
            asm volatile("s_waitcnt vmcnt(0)" ::: "memory");
        } else {
            XB_SPIN(xb_ld(&bar[XB_XGEN(b.x)]) == gen, bar);
            __builtin_amdgcn_fence(__ATOMIC_ACQUIRE, "agent");
            asm volatile("s_waitcnt vmcnt(0)" ::: "memory");
        }
    }
    __syncthreads();
}

constexpr int NWAVES = 8;
struct Frame {
    LAS unsigned char* lds; char* ldsg;
    int tid, lane, wave, vcu, G;
    unsigned char* ws;
};
enum { IN_X = 0, IN_C, IN_MODW, IN_MODB, IN_NMIX, IN_NFFN, IN_CONVIN, IN_CONVW, IN_CONVOUT, IN_FGATE, IN_FUP, IN_FDOWN, IN_QKVW, IN_QNORM, IN_KNORM, IN_AOUT, IN_RW, IN_RB, IN_EGATE, IN_EUP, IN_EDOWN, N_IN };
struct Args { const float* in[N_IN]; float* out; unsigned char* ws; int ph_lo, ph_hi, use_bar, pad; };

__device__ __forceinline__ void mod_phase(Frame& F, const float* c, const float* modw, const float* modb, float* mod) {
    LAS float* cact = (LAS float*)F.lds;
    LAS float* red = (LAS float*)(F.lds + 65536);
    constexpr int NU = 2 * (6 * DM / 128);
    if ((int)blockIdx.x >= NU) return;
    for (int i = F.tid; i < NB * DM; i += NWAVES * 64) { const int b = i / DM, d = i % DM; const float v = c[i]; cact[d * 8 + b] = v / (1.0f + __expf(-v)); }
    __syncthreads();
    for (int u = blockIdx.x; u < NU; u += F.G) {
        const int layer = u / (6 * DM / 128), col0 = (u % (6 * DM / 128)) * 128;
        const int cg = F.tid & 31, rg = F.tid >> 5;
        const float* W = modw + (size_t)layer * DM * (6 * DM) + col0 + 4 * cg;
        f32x4 acc[8];
#pragma unroll
        for (int b = 0; b < 8; ++b) acc[b] = (f32x4){0.f, 0.f, 0.f, 0.f};
#pragma unroll 8
        for (int it = 0; it < DM / 16; ++it) { const int r = rg + 16 * it; const f32x4 w = *(const f32x4*)(W + (size_t)r * (6 * DM));
            const f32x4 c0 = *(const LAS f32x4*)(cact + r * 8), c1 = *(const LAS f32x4*)(cact + r * 8 + 4);
            acc[0] += w * c0[0]; acc[1] += w * c0[1]; acc[2] += w * c0[2]; acc[3] += w * c0[3]; acc[4] += w * c1[0]; acc[5] += w * c1[1]; acc[6] += w * c1[2]; acc[7] += w * c1[3]; }
#pragma unroll
        for (int b = 0; b < 8; ++b) *(LAS f32x4*)(red + rg * 1024 + cg * 32 + b * 4) = acc[b];
        __syncthreads();
        for (int o = F.tid; o < 1024; o += NWAVES * 64) { float s = 0.f;
#pragma unroll
            for (int r = 0; r < 16; ++r) s += red[r * 1024 + o];
            const int cgo = o >> 5, b = (o >> 2) & 7, i = o & 3, col = col0 + 4 * cgo + i;
            mod[((size_t)layer * NB + b) * (6 * DM) + col] = s + modb[layer * (6 * DM) + col]; }
        __syncthreads();
    }
}
__device__ __forceinline__ void rope_table_phase(Frame& F, float* tab) {
    const int gt = blockIdx.x * (NWAVES * 64) + F.tid, NT = F.G * NWAVES * 64;
    for (int i = gt; i < SEQ * 64; i += NT) { const int pos = i >> 6, f = i & 63; const float inv = expf(-9.210340371976184f * (float)f / 64.0f); const float ang = (float)pos * inv;
        float s, co; sincosf(ang, &s, &co); tab[i] = co; tab[SEQ * 64 + i] = s; }
}
__device__ __forceinline__ void cvt_item(const float* src, int ldsrc, int k0, int n0, bf16_t* dst, int Kd, int drow0, LAS float* scr, int lane) {
    float v[32];
#pragma unroll
    for (int i = 0; i < 32; ++i) { const int kk = 2 * i + (lane >> 5); v[i] = src[(size_t)(k0 + kk) * ldsrc + n0 + (lane & 31)]; }
#pragma unroll
    for (int i = 0; i < 32; ++i) { const int kk = 2 * i + (lane >> 5); scr[kk * 33 + (lane & 31)] = v[i]; }
    LDS_WAIT(); asm volatile("" ::: "memory");
    const int c = lane & 7;
#pragma unroll
    for (int j = 0; j < 4; ++j) { const int n = (lane >> 3) + 8 * j; const LAS float* s = scr + (8 * c) * 33 + n;
        u32x4 o; o.x = pk2(s[0 * 33], s[1 * 33]); o.y = pk2(s[2 * 33], s[3 * 33]); o.z = pk2(s[4 * 33], s[5 * 33]); o.w = pk2(s[6 * 33], s[7 * 33]);
        *(u32x4*)(dst + (size_t)(drow0 + n) * Kd + k0 + 8 * c) = o; }
    LDS_WAIT(); asm volatile("" ::: "memory");
}
__device__ __forceinline__ void cvt_item8(const float* src, int ldsrc, int k0, int n0, unsigned char* dst, int Kd, int drow0, LAS float* scr, int lane) {
    float v[32];
#pragma unroll
    for (int i = 0; i < 32; ++i) { const int kk = 2 * i + (lane >> 5); v[i] = src[(size_t)(k0 + kk) * ldsrc + n0 + (lane & 31)]; }
#pragma unroll
    for (int i = 0; i < 32; ++i) { const int kk = 2 * i + (lane >> 5); scr[kk * 33 + (lane & 31)] = v[i] * W_SCALE; }
    LDS_WAIT(); asm volatile("" ::: "memory");
    const int c = lane & 7;
#pragma unroll
    for (int j = 0; j < 4; ++j) { const int n = (lane >> 3) + 8 * j; const LAS float* s = scr + (8 * c) * 33 + n;
        u32x2 o; o.x = pk4_fp8(s[0 * 33], s[1 * 33], s[2 * 33], s[3 * 33]); o.y = pk4_fp8(s[4 * 33], s[5 * 33], s[6 * 33], s[7 * 33]);
        *(u32x2*)(dst + (size_t)(drow0 + n) * Kd + k0 + 8 * c) = o; }
    LDS_WAIT(); asm volatile("" ::: "memory");
}
__device__ __forceinline__ int pair_row(int n, int s) { return 256 * (n >> 7) + 128 * s + (n & 127); }
__device__ __forceinline__ void calib_phase(Frame& F, const Args& a, LAS float* wsc_l, float* wsc_g) {
    LAS float* red = (LAS float*)F.lds;
    for (int t = 0; t < WQ_N; ++t) {
        const float* p; size_t n;
        switch (t) { case WQ_CONVIN: p = a.in[IN_CONVIN]; n = (size_t)DM * 3 * DM; break; case WQ_FGATE: p = a.in[IN_FGATE]; n = (size_t)DM * FF; break; case WQ_FUP: p = a.in[IN_FUP]; n = (size_t)DM * FF; break;
                     case WQ_QKV: p = a.in[IN_QKVW]; n = (size_t)DM * 3 * DM; break; case WQ_EGATE: p = a.in[IN_EGATE]; n = (size_t)NE * DM * FFE; break; default: p = a.in[IN_EUP]; n = (size_t)NE * DM * FFE; break; }
        float ss = 0.f;
#pragma unroll
        for (int k = 0; k < 8; ++k) { const int i = F.tid + 512 * k, chunk = i >> 10, off = i & 1023; const f32x4 v = *(const f32x4*)(p + (n / 4) * chunk + 4 * off); ss += (v.x * v.x + v.y * v.y) + (v.z * v.z + v.w * v.w); }
        ss = wave_sum(ss); if (F.lane == 0) red[F.wave] = ss;
        __syncthreads();
        if (F.tid == 0) { float tot = 0.f; for (int w = 0; w < NWAVES; ++w) tot += red[w]; const float rms = sqrtf(tot * (1.f / 16384.f)); const float sc = 127.f / (WI8_CLIP * fmaxf(rms, 1e-30f)); wsc_l[t] = sc; if (blockIdx.x == 0) wsc_g[t] = sc; }
        __syncthreads();
    }
}
__host__ __device__ __forceinline__ int qk_slot(int d) { return 32 * ((d >> 4) & 3) + 8 * ((d >> 2) & 3) + 4 * (d >> 6) + (d & 3); }
struct CvtDesc { const float* src; int ld; unsigned char* dst; int kb0; int f8; float sc; int pd0; };
__device__ __forceinline__ CvtDesc cvt_decode(int it, const Args& a, unsigned char* ws, const LAS float* wsc) {
    constexpr int I0 = (DM / 64) * (3 * DM / 32), I1 = (DM / 64) * (DM / 32), I2 = (DM / 64) * (FF / 32), I4 = (FF / 64) * (DM / 32), IE = (DM / 64) * (FFE / 32), ID = (FFE / 64) * (DM / 32);
    const float* src; int ld, K, kb, n0, drow, f8, wq = 0, pd0 = -1; unsigned char* dbase; size_t eoff = 0; int r = it;
    if (r < I0) { const int nb = 3 * DM / 64; kb = r / nb; n0 = (r % nb) * 64; src = a.in[IN_CONVIN]; ld = 3 * DM; K = DM; f8 = MD_CONVIN; wq = WQ_CONVIN; dbase = ws + WS_W1;
        drow = n0 < DM ? 2 * DM + n0 : (n0 < 2 * DM ? pair_row(n0 - DM, 0) : pair_row(n0 - 2 * DM, 1)); }
    else if ((r -= I0) < I1) { const int nb = DM / 64; kb = r / nb; n0 = (r % nb) * 64; src = a.in[IN_CONVOUT]; ld = DM; K = DM; f8 = 0; dbase = ws + WS_W2; drow = n0; }
    else if ((r -= I1) < I2) { const int nb = FF / 64; kb = r / nb; n0 = (r % nb) * 64; src = a.in[IN_FGATE]; ld = FF; K = DM; f8 = MD_FFN_GU; wq = WQ_FGATE; dbase = ws + WS_W3; drow = pair_row(n0, 0); }
    else if ((r -= I2) < I2) { const int nb = FF / 64; kb = r / nb; n0 = (r % nb) * 64; src = a.in[IN_FUP]; ld = FF; K = DM; f8 = MD_FFN_GU; wq = WQ_FUP; dbase = ws + WS_W3; drow = pair_row(n0, 1); }
    else if ((r -= I2) < I4) { const int nb = DM / 64; kb = r / nb; n0 = (r % nb) * 64; src = a.in[IN_FDOWN]; ld = DM; K = FF; f8 = F8_FFN_DN; dbase = ws + WS_W4; drow = n0; }
    else if ((r -= I4) < I0) { const int nb = 3 * DM / 64; kb = r / nb; n0 = (r % nb) * 64; src = a.in[IN_QKVW]; ld = 3 * DM; K = DM; f8 = MD_QKV; wq = WQ_QKV; dbase = ws + WS_W5; drow = n0; if (QK_FUSED && n0 < 2 * DM) { pd0 = n0 & 127; drow = n0 & ~127; } }
    else if ((r -= I0) < I1) { const int nb = DM / 64; kb = r / nb; n0 = (r % nb) * 64; src = a.in[IN_AOUT]; ld = DM; K = DM; f8 = F8_AOUT; dbase = ws + WS_W6; drow = n0; }
    else if ((r -= I1) < NE * IE) { const int e = r / IE, q = r % IE, nb = FFE / 64; kb = q / nb; n0 = (q % nb) * 64; src = a.in[IN_EGATE] + (size_t)e * DM * FFE; ld = FFE; K = DM; f8 = MD_MOE_GU; wq = WQ_EGATE; dbase = ws + WS_W7; eoff = (size_t)e * 2 * FFE * DM; drow = pair_row(n0, 0); }
    else if ((r -= NE * IE) < NE * IE) { const int e = r / IE, q = r % IE, nb = FFE / 64; kb = q / nb; n0 = (q % nb) * 64; src = a.in[IN_EUP] + (size_t)e * DM * FFE; ld = FFE; K = DM; f8 = MD_MOE_GU; wq = WQ_EUP; dbase = ws + WS_W7; eoff = (size_t)e * 2 * FFE * DM; drow = pair_row(n0, 1); }
    else { r -= NE * IE; const int e = r / ID, q = r % ID, nb = DM / 64; kb = q / nb; n0 = (q % nb) * 64; src = a.in[IN_EDOWN] + (size_t)e * FFE * DM; ld = DM; K = FFE; f8 = MOE_F8; dbase = ws + WS_W8; eoff = (size_t)e * DM * FFE; drow = n0; }
    const int es = f8 ? 1 : 2;
    CvtDesc d; d.src = src + (size_t)(kb * 32) * ld + n0; d.ld = ld; d.dst = dbase + (eoff + (size_t)(drow >> 8) * 256 * K) * es + (size_t)(drow & 255) * 32; d.kb0 = kb * 32 * es; d.f8 = f8; d.sc = f8 == 1 ? W_SCALE : (f8 == 2 ? wsc[wq] : 1.0f); d.pd0 = pd0; return d;
}
__device__ __forceinline__ void cvt_load(const CvtDesc& d, float (&v)[32], int lane) {
#pragma unroll
    for (int i = 0; i < 32; ++i) v[i] = __builtin_nontemporal_load(d.src + (size_t)i * d.ld + lane);
}
__device__ __forceinline__ unsigned pk4_i8_magic(float a, float b, float c, float d, float sc) {
    const unsigned ua = __builtin_bit_cast(unsigned, __builtin_fmaf(a, sc, 12582912.f)), ub = __builtin_bit_cast(unsigned, __builtin_fmaf(b, sc, 12582912.f)), uc = __builtin_bit_cast(unsigned, __builtin_fmaf(c, sc, 12582912.f)), ud = __builtin_bit_cast(unsigned, __builtin_fmaf(d, sc, 12582912.f));
    const unsigned lo = __builtin_amdgcn_perm(ub, ua, 0x0c0c0400u), hi = __builtin_amdgcn_perm(ud, uc, 0x04000c0cu);
    return lo | hi; }
__device__ __forceinline__ void cvt_store(const CvtDesc& d, const float (&v)[32], LAS float* scr, int lane) {
    (void)scr;
    unsigned char* p = d.dst + (size_t)(d.pd0 >= 0 ? qk_slot(d.pd0 + lane) : lane) * 32 + (size_t)(d.kb0 >> 5) * 8192;
    const float sc = d.sc;
    if (d.f8 == 1) {
#pragma unroll
        for (int h = 0; h < 2; ++h) { u32x4 o;
            o.x = pk4_fp8(v[16 * h + 0] * sc, v[16 * h + 1] * sc, v[16 * h + 2] * sc, v[16 * h + 3] * sc); o.y = pk4_fp8(v[16 * h + 4] * sc, v[16 * h + 5] * sc, v[16 * h + 6] * sc, v[16 * h + 7] * sc);
            o.z = pk4_fp8(v[16 * h + 8] * sc, v[16 * h + 9] * sc, v[16 * h + 10] * sc, v[16 * h + 11] * sc); o.w = pk4_fp8(v[16 * h + 12] * sc, v[16 * h + 13] * sc, v[16 * h + 14] * sc, v[16 * h + 15] * sc);
            *(u32x4*)(p + 16 * h) = o; } }
    else if (d.f8 == 2) { const float lim = 127.f / sc;
#define CL(x) __builtin_amdgcn_fmed3f(x, -lim, lim)
#pragma unroll
        for (int h = 0; h < 2; ++h) { u32x4 o;
            o.x = pk4_i8_magic(CL(v[16 * h + 0]), CL(v[16 * h + 1]), CL(v[16 * h + 2]), CL(v[16 * h + 3]), sc); o.y = pk4_i8_magic(CL(v[16 * h + 4]), CL(v[16 * h + 5]), CL(v[16 * h + 6]), CL(v[16 * h + 7]), sc);
            o.z = pk4_i8_magic(CL(v[16 * h + 8]), CL(v[16 * h + 9]), CL(v[16 * h + 10]), CL(v[16 * h + 11]), sc); o.w = pk4_i8_magic(CL(v[16 * h + 12]), CL(v[16 * h + 13]), CL(v[16 * h + 14]), CL(v[16 * h + 15]), sc);
            *(u32x4*)(p + 16 * h) = o; }
#undef CL
    }
    else {
#pragma unroll
        for (int h = 0; h < 4; ++h) { u32x4 o; o.x = pk2(v[8 * h + 0], v[8 * h + 1]); o.y = pk2(v[8 * h + 2], v[8 * h + 3]); o.z = pk2(v[8 * h + 4], v[8 * h + 5]); o.w = pk2(v[8 * h + 6], v[8 * h + 7]);
            *(u32x4*)(p + (size_t)(h >> 1) * 8192 + 16 * (h & 1)) = o; } }
}
constexpr int CVT_I0 = (DM / 64) * (3 * DM / 32), CVT_I1 = (DM / 64) * (DM / 32), CVT_I2 = (DM / 64) * (FF / 32), CVT_I4 = (FF / 64) * (DM / 32), CVT_IE = (DM / 64) * (FFE / 32), CVT_ID = (FFE / 64) * (DM / 32);
constexpr int CVT_M0 = CVT_I0 + CVT_I1 + 2 * CVT_I2 + CVT_I4 + CVT_I0 + CVT_I1;
constexpr int CVT_NITEMS = CVT_M0 + 2 * NE * CVT_IE + NE * CVT_ID;
constexpr int CVT_P0 = CVT_I0 + CVT_I1;
constexpr int CVT_S1 = CVT_P0 + 34816, CVT_S1B = CVT_S1 + 22528, CVT_S2 = CVT_S1B + 51200, CVT_S2B = CVT_S2 + 34816, CVT_S3 = CVT_S2B + 29184;
static_assert(CVT_S1 >= CVT_M0 && CVT_S3 < CVT_NITEMS, "slice boundaries");
constexpr int CVT_S1_UNUSED_ = 0;
static_assert(CVT_S2 < CVT_NITEMS, "slices");
__device__ __forceinline__ void convert_phase(Frame& F, const Args& a, const LAS float* wsc, const int lo, const int NITEMS) {
    LAS float* scr = (LAS float*)(F.lds + F.wave * 16384);
    const int gw = F.vcu * NWAVES + F.wave, NGW = F.G * NWAVES;
    int it = lo + gw; if (it >= NITEMS) return;
    float va[32], vb[32], vc[32];
    CvtDesc da = cvt_decode(it, a, F.ws, wsc), db = da, dc = da; cvt_load(da, va, F.lane);
    if (it + NGW < NITEMS) { db = cvt_decode(it + NGW, a, F.ws, wsc); cvt_load(db, vb, F.lane); }
    for (;;) {
        if (it + 2 * NGW < NITEMS) { dc = cvt_decode(it + 2 * NGW, a, F.ws, wsc); cvt_load(dc, vc, F.lane); }
        cvt_store(da, va, scr, F.lane);
        if (it + NGW >= NITEMS) break; it += NGW;
        if (it + 2 * NGW < NITEMS) { da = cvt_decode(it + 2 * NGW, a, F.ws, wsc); cvt_load(da, va, F.lane); }
        cvt_store(db, vb, scr, F.lane);
        if (it + NGW >= NITEMS) break; it += NGW;
        if (it + 2 * NGW < NITEMS) { db = cvt_decode(it + 2 * NGW, a, F.ws, wsc); cvt_load(db, vb, F.lane); }
        cvt_store(dc, vc, scr, F.lane);
        if (it + NGW >= NITEMS) break; it += NGW;
    }
}
__device__ __forceinline__ void cvt_slice(Frame& F, const Args& a, const float* wsc_g, int lo, int hi) {
    LAS float* wsc_l = (LAS float*)(F.lds + PHASE_LDS);
    if (F.tid < WQ_N) wsc_l[F.tid] = __builtin_bit_cast(float, ld_i32_agent((const int*)wsc_g + F.tid));
    __syncthreads();
    convert_phase(F, a, wsc_l, lo, hi);
    __syncthreads();
}
template <int OM, bool XB = false> __device__ __forceinline__ void norm_row(const void* xrow, const float* gain, const float* shift, const float* scale, void* orow, int lane, f32x4 (&hv)[8], float* rs_out = nullptr) {
    const f32x4* xr = (const f32x4*)xrow + lane; const u32x2* xb = (const u32x2*)xrow + lane;
    float s = 0.f;
#pragma unroll
    for (int j = 0; j < 8; ++j) { if constexpr (XB) { const u32x2 w = xb[64 * j]; hv[j] = (f32x4){hf_lo(w.x), hf_hi(w.x), hf_lo(w.y), hf_hi(w.y)}; } else hv[j] = xr[64 * j]; s += (hv[j].x * hv[j].x + hv[j].y * hv[j].y) + (hv[j].z * hv[j].z + hv[j].w * hv[j].w); }
    const float rstd = 1.0f / sqrtf(wave_sum(s) * (1.f / DM) + NORM_EPS);
    unsigned long long* o8 = (unsigned long long*)orow + lane; unsigned* o4 = (unsigned*)orow + lane;
#pragma unroll
    for (int j = 0; j < 8; ++j) { const f32x4 g = ((const f32x4*)gain)[lane + 64 * j], sh = ((const f32x4*)shift)[lane + 64 * j], sc = ((const f32x4*)scale)[lane + 64 * j];
        hv[j] = (hv[j] * rstd * g) * (sc + 1.0f) + sh; }
    float qs = 1.f;
    if constexpr (OM >= 2) { float mx = 1e-20f;
#pragma unroll
        for (int j = 0; j < 8; ++j) mx = fmaxf(mx, fmaxf(fmaxf(fabsf(hv[j].x), fabsf(hv[j].y)), fmaxf(fabsf(hv[j].z), fabsf(hv[j].w))));
#pragma unroll
        for (int o = 1; o < 64; o <<= 1) mx = fmaxf(mx, __shfl_xor(mx, o));
        qs = 127.f / mx; if (lane == 0) *rs_out = mx * (1.f / 127.f); }
#pragma unroll
    for (int j = 0; j < 8; ++j) {
        if constexpr (OM == 1) o4[64 * j] = pk4_fp8(hv[j].x * HS_SCALE, hv[j].y * HS_SCALE, hv[j].z * HS_SCALE, hv[j].w * HS_SCALE);
        else if constexpr (OM >= 2) o4[64 * j] = pk4_i8(hv[j].x * qs, hv[j].y * qs, hv[j].z * qs, hv[j].w * qs);
        else o8[64 * j] = (unsigned long long)cvt_pk_bf16(hv[j].x, hv[j].y) | ((unsigned long long)cvt_pk_bf16(hv[j].z, hv[j].w) << 32); }
}
__device__ __forceinline__ void norm_vecs(const float* gain, const float* shift, const float* scale, int lane, f32x4 (&gs)[8], f32x4 (&sh)[8]) {
#pragma unroll
    for (int j = 0; j < 8; ++j) { const f32x4 g = ((const f32x4*)gain)[lane + 64 * j], sc = ((const f32x4*)scale)[lane + 64 * j]; gs[j] = g * (sc + 1.0f); sh[j] = ((const f32x4*)shift)[lane + 64 * j]; }
}
template <int OM, bool XB = false> __device__ __forceinline__ void norm_row_r(const void* xrow, const f32x4 (&gs)[8], const f32x4 (&sh)[8], void* orow, int lane, f32x4 (&hv)[8], float* rs_out = nullptr) {
    const f32x4* xr = (const f32x4*)xrow + lane; const u32x2* xb = (const u32x2*)xrow + lane;
    float s = 0.f;
#pragma unroll
    for (int j = 0; j < 8; ++j) { if constexpr (XB) { const u32x2 w = xb[64 * j]; hv[j] = (f32x4){hf_lo(w.x), hf_hi(w.x), hf_lo(w.y), hf_hi(w.y)}; } else hv[j] = xr[64 * j]; s += (hv[j].x * hv[j].x + hv[j].y * hv[j].y) + (hv[j].z * hv[j].z + hv[j].w * hv[j].w); }
    const float rstd = 1.0f / sqrtf(wave_sum(s) * (1.f / DM) + NORM_EPS);
    unsigned long long* o8 = (unsigned long long*)orow + lane; unsigned* o4 = (unsigned*)orow + lane;
#pragma unroll
    for (int j = 0; j < 8; ++j) hv[j] = (hv[j] * rstd) * gs[j] + sh[j];
    float qs = 1.f;
    if constexpr (OM >= 2) { float mx = 1e-20f;
#pragma unroll
        for (int j = 0; j < 8; ++j) mx = fmaxf(mx, fmaxf(fmaxf(fabsf(hv[j].x), fabsf(hv[j].y)), fmaxf(fabsf(hv[j].z), fabsf(hv[j].w))));
#pragma unroll
        for (int o = 1; o < 64; o <<= 1) mx = fmaxf(mx, __shfl_xor(mx, o));
        qs = 127.f / mx; if (lane == 0) *rs_out = mx * (1.f / 127.f); }
#pragma unroll
    for (int j = 0; j < 8; ++j) {
        if constexpr (OM == 1) o4[64 * j] = pk4_fp8(hv[j].x * HS_SCALE, hv[j].y * HS_SCALE, hv[j].z * HS_SCALE, hv[j].w * HS_SCALE);
        else if constexpr (OM >= 2) o4[64 * j] = pk4_i8(hv[j].x * qs, hv[j].y * qs, hv[j].z * qs, hv[j].w * qs);
        else o8[64 * j] = (unsigned long long)cvt_pk_bf16(hv[j].x, hv[j].y) | ((unsigned long long)cvt_pk_bf16(hv[j].z, hv[j].w) << 32); }
}
template <int OM, bool XB = false> __device__ __forceinline__ void norm_phase(Frame& F, const void* x, const float* gain, const float* mod_l, int shift_idx, void* h, float* rs) {
    const int gw = F.vcu * NWAVES + F.wave, NGW = F.G * NWAVES;
    if (NGW == MTOK / 8 && NB == 8) {
        const int b = gw & 7, r0 = gw >> 3; const float* mb = mod_l + (size_t)b * (6 * DM);
        f32x4 gs[8], sh[8]; norm_vecs(gain, mb + shift_idx * DM, mb + (shift_idx + 1) * DM, F.lane, gs, sh);
        for (int k = 0; k < 8; ++k) { const int m = b * SEQ + r0 + 256 * k;
            f32x4 hv[8]; norm_row_r<OM, XB>((const unsigned char*)x + (size_t)m * DM * (XB ? 2 : 4), gs, sh, (unsigned char*)h + (size_t)m * DM * (OM ? 1 : 2), F.lane, hv, rs + m); }
        return; }
    for (int m0 = 8 * gw; m0 < MTOK; m0 += 8 * NGW) { const int b = m0 >> 11; const float* mb = mod_l + (size_t)b * (6 * DM);
        f32x4 gs[8], sh[8]; norm_vecs(gain, mb + shift_idx * DM, mb + (shift_idx + 1) * DM, F.lane, gs, sh);
        for (int k = 0; k < 8; ++k) { const int m = m0 + k;
            f32x4 hv[8]; norm_row_r<OM, XB>((const unsigned char*)x + (size_t)m * DM * (XB ? 2 : 4), gs, sh, (unsigned char*)h + (size_t)m * DM * (OM ? 1 : 2), F.lane, hv, rs + m); } }
}
__device__ __forceinline__ void norm_router_phase(Frame& F, const void* x, const float* gain, const float* mod_l, const float* rw, const float* rb, bf16_t* h,
                                                  int* tok_e, float* tok_w, int* tok_rank, int* chunk_cnt, float* rs_tok) {
    LAS float* rwT = (LAS float*)F.lds;
    LAS int* le = (LAS int*)(F.lds + 65536);
    for (int i = F.tid; i < DM * NE; i += NWAVES * 64) { const int d = i >> 3, e = i & 7; rwT[e * DM + d] = rw[i]; }
    __syncthreads();
    for (int u = blockIdx.x; u < MTOK / 64; u += F.G) {
        f32x4 gs[8], sh[8]; { const float* mb = mod_l + (size_t)((u * 64) >> 11) * (6 * DM); norm_vecs(gain, mb + 3 * DM, mb + 4 * DM, F.lane, gs, sh); }
        for (int rr = 0; rr < 8; ++rr) { const int lr = F.wave * 8 + rr, m = u * 64 + lr;
            f32x4 hv[8]; norm_row_r<MD_MOE_GU == 2 ? 3 : 0, X_BF16 != 0>((const unsigned char*)x + (size_t)m * DM * (X_BF16 ? 2 : 4), gs, sh, (unsigned char*)h + (size_t)m * DM * (MD_MOE_GU == 2 ? 1 : 2), F.lane, hv, rs_tok + m);
            float lg[8];
#pragma unroll
            for (int e = 0; e < 8; ++e) { float s = 0.f;
#pragma unroll
                for (int j = 0; j < 8; ++j) { const f32x4 w = *(const LAS f32x4*)(rwT + e * DM + 4 * F.lane + 256 * j); s += (hv[j].x * w.x + hv[j].y * w.y) + (hv[j].z * w.z + hv[j].w * w.w); }
                lg[e] = wave_sum(s) + rb[e]; }
            int i1 = 0; float m1 = lg[0];
#pragma unroll
            for (int e = 1; e < 8; ++e) if (lg[e] > m1) { m1 = lg[e]; i1 = e; }
            int i2 = -1; float m2 = -__builtin_inff();
#pragma unroll
            for (int e = 0; e < 8; ++e) if (e != i1 && lg[e] > m2) { m2 = lg[e]; i2 = e; }
            const float w1 = 1.0f / (1.0f + __expf(m2 - m1));
            if (F.lane == 0) { tok_e[2 * m] = i1; tok_e[2 * m + 1] = i2; tok_w[2 * m] = w1; tok_w[2 * m + 1] = 1.0f - w1; le[2 * lr] = i1; le[2 * lr + 1] = i2; }
        }
        __syncthreads();
        if (F.wave == 0) { const int e0 = le[2 * F.lane], e1 = le[2 * F.lane + 1]; const unsigned long long lt = (1ull << F.lane) - 1ull; int r0 = 0, r1 = 0;
#pragma unroll
            for (int e = 0; e < 8; ++e) { const unsigned long long b0 = __ballot(e0 == e), b1 = __ballot(e1 == e); const int below = __popcll(b0 & lt) + __popcll(b1 & lt);
                if (e0 == e) r0 = below; if (e1 == e) r1 = below; if (F.lane == 0) chunk_cnt[u * 8 + e] = __popcll(b0) + __popcll(b1); }
            const int m = u * 64 + F.lane; tok_rank[2 * m] = r0; tok_rank[2 * m + 1] = r1; }
        __syncthreads();
    }
}
__device__ __forceinline__ void scatter_phase(Frame& F, const int* chunk_cnt, const int* tok_e, const int* tok_rank, int* tok_pos, const bf16_t* h, unsigned char* hs, int* mt_e, int* n_mt, float* rs, const float* rs_tok) {
    LAS int* pref = (LAS int*)F.lds;
    LAS int* tot = (LAS int*)(F.lds + 8192);
    { const int e = F.wave; int c[4]; int s = 0;
#pragma unroll
      for (int k = 0; k < 4; ++k) { c[k] = ld_i32_agent(chunk_cnt + (4 * F.lane + k) * 8 + e); s += c[k]; }
      int inc = s;
#pragma unroll
      for (int o = 1; o < 64; o <<= 1) { const int v = __shfl_up(inc, o); if (F.lane >= o) inc += v; }
      int ex = inc - s;
#pragma unroll
      for (int k = 0; k < 4; ++k) { pref[e * 256 + 4 * F.lane + k] = ex; ex += c[k]; }
      if (F.lane == 63) tot[e] = inc; }
    __syncthreads();
    if (F.tid == 0) { int ts = 0; for (int e = 0; e < 8; ++e) { tot[8 + e] = ts; const int nt = (tot[e] + 255) >> 8; if (blockIdx.x == 0) for (int k = 0; k < nt; ++k) mt_e[ts + k] = e; ts += nt; } if (blockIdx.x == 0) *n_mt = ts; }
    __syncthreads();
    for (int u = blockIdx.x; u < MTOK / 64; u += F.G) {
        for (int q = F.wave; q < 128; q += NWAVES) { const int m = u * 64 + (q >> 1), k = q & 1; const int e = ld_i32_agent(tok_e + 2 * m + k), rk = ld_i32_agent(tok_rank + 2 * m + k);
            const int pos = 256 * tot[8 + e] + pref[e * 256 + u] + rk;
            if (F.lane == 0) tok_pos[2 * m + k] = pos;
            const u32x4* s = (const u32x4*)(h + (size_t)m * DM) + F.lane;
            if (MD_MOE_GU == 2) {
                const u32x4* s8 = (const u32x4*)((const unsigned char*)h + (size_t)m * DM) + F.lane; u32x4* d = (u32x4*)(hs + (size_t)pos * DM) + F.lane;
                d[0] = s8[0]; d[64] = s8[64];
                if (F.lane == 0) rs[pos] = __builtin_bit_cast(float, ld_i32_agent((const int*)rs_tok + m)); }
            else if (MD_MOE_GU == 1) { u32x2* d = (u32x2*)(hs + (size_t)pos * DM) + F.lane;
#pragma unroll
                for (int j = 0; j < 4; ++j) { const u32x4 w = s[64 * j]; u32x2 o;
                    o.x = pk4_fp8(bf_lo(w.x) * HS_SCALE, bf_hi(w.x) * HS_SCALE, bf_lo(w.y) * HS_SCALE, bf_hi(w.y) * HS_SCALE); o.y = pk4_fp8(bf_lo(w.z) * HS_SCALE, bf_hi(w.z) * HS_SCALE, bf_lo(w.w) * HS_SCALE, bf_hi(w.w) * HS_SCALE);
                    d[64 * j] = o; } }
            else { u32x4* d = (u32x4*)(hs + (size_t)pos * DM * 2) + F.lane;
#pragma unroll
                for (int j = 0; j < 4; ++j) d[64 * j] = s[64 * j]; } }
    }
}
__device__ __forceinline__ void conv_phase(Frame& F, const bf16_t* U, const bf16_t* BG, const float* cw, bf16_t* W) {
    const int gw = F.vcu * NWAVES + F.wave, NGW = F.G * NWAVES;
    for (int m = gw; m < MTOK; m += NGW) { const int s = m & (SEQ - 1);
#pragma unroll
        for (int j = 0; j < 4; ++j) { const int d = 8 * F.lane + 512 * j;
            const u32x4 u0 = *(const u32x4*)(U + (size_t)m * DM + d), bg = *(const u32x4*)(BG + (size_t)m * DM + d);
            const u32x4 z = {0u, 0u, 0u, 0u};
            const u32x4 u1 = s >= 1 ? *(const u32x4*)(U + (size_t)(m - 1) * DM + d) : z, u2 = s >= 2 ? *(const u32x4*)(U + (size_t)(m - 2) * DM + d) : z;
            const f32x4 k0a = *(const f32x4*)(cw + d), k0b = *(const f32x4*)(cw + d + 4), k1a = *(const f32x4*)(cw + DM + d), k1b = *(const f32x4*)(cw + DM + d + 4), k2a = *(const f32x4*)(cw + 2 * DM + d), k2b = *(const f32x4*)(cw + 2 * DM + d + 4);
            float r[8];
#define CV(i, uw0, uw1, uw2, bw, ka, kb, kc, LOHI) r[i] = LOHI(bw) * (ka * LOHI(uw2) + kb * LOHI(uw1) + kc * LOHI(uw0))
            CV(0, u0.x, u1.x, u2.x, bg.x, k0a[0], k1a[0], k2a[0], bf_lo); CV(1, u0.x, u1.x, u2.x, bg.x, k0a[1], k1a[1], k2a[1], bf_hi);
            CV(2, u0.y, u1.y, u2.y, bg.y, k0a[2], k1a[2], k2a[2], bf_lo); CV(3, u0.y, u1.y, u2.y, bg.y, k0a[3], k1a[3], k2a[3], bf_hi);
            CV(4, u0.z, u1.z, u2.z, bg.z, k0b[0], k1b[0], k2b[0], bf_lo); CV(5, u0.z, u1.z, u2.z, bg.z, k0b[1], k1b[1], k2b[1], bf_hi);
            CV(6, u0.w, u1.w, u2.w, bg.w, k0b[2], k1b[2], k2b[2], bf_lo); CV(7, u0.w, u1.w, u2.w, bg.w, k0b[3], k1b[3], k2b[3], bf_hi);
#undef CV
            u32x4 o; o.x = cvt_pk_bf16(r[0], r[1]); o.y = cvt_pk_bf16(r[2], r[3]); o.z = cvt_pk_bf16(r[4], r[5]); o.w = cvt_pk_bf16(r[6], r[7]);
            *(u32x4*)(W + (size_t)m * DM + d) = o; } }
}
__device__ __forceinline__ void qkprep_phase(Frame& F, bf16_t* qkv, const float* qg, const float* kg, const float* rope, float* kmean) {
    LAS float* part = (LAS float*)F.lds;
    const int rg = F.lane >> 4, ds = F.lane & 15, d0 = 8 * ds, fi = 8 * (ds & 7);
    for (int u = F.vcu; u < 2 * NB * NH * NBLK; u += F.G) {
        const int which = u / (NB * NH * NBLK), r = u % (NB * NH * NBLK), b = r / (NH * NBLK), hh = (r / NBLK) % NH, blk = r % NBLK;
        const float* gn = which ? kg : qg;
        const f32x4 ga = *(const f32x4*)(gn + d0), gb = *(const f32x4*)(gn + d0 + 4);
        float ks[8];
#pragma unroll
        for (int i = 0; i < 8; ++i) ks[i] = 0.f;
        for (int it = 0; it < 8; ++it) {
            const int pos = blk * MBLK + F.wave * 32 + it * 4 + rg; const size_t m = (size_t)b * SEQ + pos;
            bf16_t* p = qkv + m * 6144 + which * DM + hh * HD + d0;
            const u32x4 w = *(const u32x4*)p;
            float v[8] = {bf_lo(w.x), bf_hi(w.x), bf_lo(w.y), bf_hi(w.y), bf_lo(w.z), bf_hi(w.z), bf_lo(w.w), bf_hi(w.w)};
            float ss = 0.f;
#pragma unroll
            for (int i = 0; i < 8; ++i) ss += v[i] * v[i];
            ss += __shfl_xor(ss, 1); ss += __shfl_xor(ss, 2); ss += __shfl_xor(ss, 4); ss += __shfl_xor(ss, 8);
            const float rstd = 1.0f / sqrtf(ss * (1.f / HD) + NORM_EPS);
            const float g8[8] = {ga[0], ga[1], ga[2], ga[3], gb[0], gb[1], gb[2], gb[3]};
            const f32x4 ca = *(const f32x4*)(rope + pos * 64 + fi), cb = *(const f32x4*)(rope + pos * 64 + fi + 4), sa = *(const f32x4*)(rope + SEQ * 64 + pos * 64 + fi), sb = *(const f32x4*)(rope + SEQ * 64 + pos * 64 + fi + 4);
            const float c8[8] = {ca[0], ca[1], ca[2], ca[3], cb[0], cb[1], cb[2], cb[3]}, s8[8] = {sa[0], sa[1], sa[2], sa[3], sb[0], sb[1], sb[2], sb[3]};
            float o[8];
#pragma unroll
            for (int i = 0; i < 8; ++i) { const float y = v[i] * rstd * g8[i]; const float yo = __shfl_xor(y, 8); o[i] = (ds < 8) ? (y * c8[i] - yo * s8[i]) : (y * c8[i] + yo * s8[i]); ks[i] += o[i]; }
            u32x4 ow; ow.x = cvt_pk_bf16(o[0], o[1]); ow.y = cvt_pk_bf16(o[2], o[3]); ow.z = cvt_pk_bf16(o[4], o[5]); ow.w = cvt_pk_bf16(o[6], o[7]);
            *(u32x4*)p = ow;
        }
        if (which) {
#pragma unroll
            for (int i = 0; i < 8; ++i) { ks[i] += __shfl_xor(ks[i], 16); ks[i] += __shfl_xor(ks[i], 32); }
            if (rg == 0) {
#pragma unroll
                for (int i = 0; i < 8; ++i) part[F.wave * 128 + d0 + i] = ks[i]; }
            __syncthreads();
            if (F.tid < 128) { float s = 0.f;
#pragma unroll
                for (int w = 0; w < 8; ++w) s += part[w * 128 + F.tid];
                kmean[(((size_t)b * NH + hh) * NBLK + blk) * HD + F.tid] = s * (1.f / MBLK); }
            __syncthreads();
        }
    }
}
__device__ __forceinline__ moba::BlockRef attn_ref(int item, int pass, const bf16_t* qkv, unsigned char* O, const float* kmean) {
    const int bh = item >> 2, x = item & 3, qb = pass ? 7 - x : x, b = bh >> 4, hh = bh & 15;
    moba::BlockRef r; const size_t row0 = (size_t)b * SEQ;
    r.Q = qkv + (row0 + (size_t)qb * 256) * 6144 + hh * HD; r.K = qkv + row0 * 6144 + DM + hh * HD; r.V = qkv + row0 * 6144 + 2 * DM + hh * HD;
    r.O = O + ((row0 + (size_t)qb * 256) * DM + hh * HD) * (F8_AOUT ? 1 : 2); r.P0 = qb * 256; r.km = kmean + (size_t)bh * NBLK * HD;
    return r;
}
__device__ __forceinline__ void attn_phase(Frame& F, const bf16_t* qkv, unsigned char* O, const float* kmean, int i0 = 0, int i1 = 1 << 20) {
    const int stride = F.G; const long tot_ = (long)F.vcu + (long)i1 * stride; const int total = tot_ < NB * NH * 4 ? (int)tot_ : NB * NH * 4;
    int L = F.vcu + i0 * stride; if (L >= total) return;
    int pass = 0;
    moba::BlockRef cur = attn_ref(L, 0, qkv, O, kmean);
    moba::Seam S;
    LAS char* lds = (LAS char*)F.lds;
    moba::moba_prime(cur, lds, S);
    for (;;) {
        const bool more_pass = pass == 0, more_item = L + stride < total, last = !more_pass && !more_item;
        int passn = pass + 1, Ln = L;
        if (!more_pass) { passn = 0; Ln = more_item ? L + stride : L; }
        const moba::BlockRef nxt = last ? cur : attn_ref(Ln, passn, qkv, O, kmean);
        moba::moba_block(cur, nxt, lds, S);
        if (last) break;
        cur = nxt; pass = passn; L = Ln;
    }
}

#ifdef ATTN_PROBE
__device__ __forceinline__ void attn_probe_phase(Frame& F, const bf16_t* qkv, const bf16_t* O, const float* kmean, unsigned* ctl) {
    LAS float* qs = (LAS float*)(F.lds) + F.wave * 128;
    LAS float* sc = (LAS float*)(F.lds + 4096) + F.wave * 1024;
    const int gw = F.vcu * NWAVES + F.wave, NGW = F.G * NWAVES, lane = F.lane;
    for (int s = gw; s < 8192; s += NGW) {
        const int b = s & 7, hh = (s >> 3) & 15; int qpos = (s * 977 + (s >> 7) * 13) & 2047;
        if ((s & 31) == 0) qpos = ((s >> 5) & 7) * 256; if ((s & 31) == 1) qpos = ((s >> 5) & 7) * 256 + 255; if ((s & 31) == 2) qpos = ((s >> 5) & 7) * 256 + 1;
        const int own = qpos >> 8; const size_t row0 = (size_t)b * SEQ;
        const bf16_t* qp = qkv + (row0 + qpos) * 6144 + hh * HD;
        { const unsigned w = *(const unsigned*)(qp + 2 * lane); qs[2 * lane] = bf_lo(w); qs[2 * lane + 1] = bf_hi(w); }
        LDS_WAIT(); asm volatile("" ::: "memory");
        unsigned sel = 0u; const float* km = kmean + ((size_t)(b * NH + hh) * NBLK) * HD;
        if (own > 0) { if (own <= TOPK) sel = (1u << own) - 1u; else { float g[7];
#pragma unroll
            for (int j = 0; j < 7; ++j) { g[j] = -__builtin_inff(); if (j < own) { float a = 0.f; _Pragma("unroll 1") for (int d = 0; d < HD; ++d) a = fmaf(qs[d], km[j * HD + d], a); g[j] = a; } }
#pragma unroll
            for (int k = 0; k < TOPK; ++k) { float best = -__builtin_inff(); int bi = 0;
#pragma unroll
                for (int j = 6; j >= 0; --j) { const bool ok = (j < own) && !((sel >> j) & 1u) && (g[j] >= best); best = ok ? g[j] : best; bi = ok ? j : bi; } sel |= 1u << bi; } } }
        int nk = 0; float mx = -__builtin_inff();
        _Pragma("unroll 1") for (int j = 0; j <= own; ++j) { if (j < own && !((sel >> j) & 1u)) continue;
            _Pragma("unroll 1") for (int i = lane; i < 256; i += 64) { const int pos = j * 256 + i; const bf16_t* kp = qkv + (row0 + pos) * 6144 + DM + hh * HD; float a = 0.f;
                _Pragma("unroll 4") for (int d = 0; d < HD; d += 2) { const unsigned w = *(const unsigned*)(kp + d); a = fmaf(qs[d], bf_lo(w), a); a = fmaf(qs[d + 1], bf_hi(w), a); }
                a *= 0.08838834764831845f; if (j == own && pos > qpos) a = -__builtin_inff(); sc[nk + i] = a; mx = fmaxf(mx, a); }
            nk += 256; }
        for (int o = 1; o < 64; o <<= 1) mx = fmaxf(mx, __shfl_xor(mx, o));
        LDS_WAIT(); asm volatile("" ::: "memory");
        float l = 0.f;
        _Pragma("unroll 1") for (int i = lane; i < nk; i += 64) { const float p = __expf(sc[i] - mx); sc[i] = p; l += p; }
        l = wave_sum(l);
        LDS_WAIT(); asm volatile("" ::: "memory");
        float o0 = 0.f, o1 = 0.f; int kk = 0;
        _Pragma("unroll 1") for (int j = 0; j <= own; ++j) { if (j < own && !((sel >> j) & 1u)) continue;
            _Pragma("unroll 4") for (int i = 0; i < 256; ++i) { const float p = sc[kk + i]; const unsigned w = *(const unsigned*)(qkv + (row0 + j * 256 + i) * 6144 + 2 * DM + hh * HD + 2 * lane); o0 = fmaf(p, bf_lo(w), o0); o1 = fmaf(p, bf_hi(w), o1); }
            kk += 256; }
        o0 /= l; o1 /= l;
        const unsigned ow = *(const unsigned*)(O + (row0 + qpos) * DM + hh * HD + 2 * lane);
        float err = fmaxf(fabsf(o0 - bf_lo(ow)), fabsf(o1 - bf_hi(ow))), mag = fmaxf(fabsf(o0), fabsf(o1));
        for (int o = 1; o < 64; o <<= 1) { err = fmaxf(err, __shfl_xor(err, o)); mag = fmaxf(mag, __shfl_xor(mag, o)); }
        const float rel = err / (mag + 1e-9f);
        if (lane == 0) { atomicMax(ctl + 8, __float_as_uint(rel)); if (rel > 0.02f) atomicAdd(ctl + 9, 1u); }
        LDS_WAIT(); asm volatile("" ::: "memory");
    }
}
#endif
__device__ __forceinline__ void moe_y8(const bf16_t* Y, const float* slabs, int pos, int d, int S, float ysc, float (&y)[8]) {
    if (pos < 128 * 256) { const u32x4 w = *(const u32x4*)(Y + (size_t)pos * DM + d);
        y[0] = bf_lo(w.x); y[1] = bf_hi(w.x); y[2] = bf_lo(w.y); y[3] = bf_hi(w.y); y[4] = bf_lo(w.z); y[5] = bf_hi(w.z); y[6] = bf_lo(w.w); y[7] = bf_hi(w.w); return; }
    const int ui = ((pos >> 8) - 128) * (DM / 256) + (d >> 8); const float* p = slabs + ((size_t)ui * S) * 65536 + (size_t)(pos & 255) * 256 + (d & 255);
    f32x4 a = {0.f, 0.f, 0.f, 0.f}, b = {0.f, 0.f, 0.f, 0.f};
    for (int k = 0; k < S; ++k) { a += *(const f32x4*)(p + (size_t)k * 65536); b += *(const f32x4*)(p + (size_t)k * 65536 + 4); }
    y[0] = a[0] * ysc; y[1] = a[1] * ysc; y[2] = a[2] * ysc; y[3] = a[3] * ysc; y[4] = b[0] * ysc; y[5] = b[1] * ysc; y[6] = b[2] * ysc; y[7] = b[3] * ysc;
}
__device__ __forceinline__ void combine_phase(Frame& F, const void* X, const float* gate, const bf16_t* Y, const float* slabs, int S, float ysc, const int* tok_pos, const float* tok_w, float* out, float pf = 1.0f) {
    const int gw = F.vcu * NWAVES + F.wave, NGW = F.G * NWAVES;
    unsigned long long npos = gw < MTOK ? __hip_atomic_load((const unsigned long long*)tok_pos + gw, RLX_AGENT) : 0ull, nw = gw < MTOK ? __hip_atomic_load((const unsigned long long*)tok_w + gw, RLX_AGENT) : 0ull;
    for (int m = gw; m < MTOK; m += NGW) { const int b = m >> 11; const float* g = gate + (size_t)b * (6 * DM);
        const int p0 = (int)(unsigned)npos, p1 = (int)(unsigned)(npos >> 32); const float w0 = __builtin_bit_cast(float, (unsigned)nw), w1 = __builtin_bit_cast(float, (unsigned)(nw >> 32));
        if (m + NGW < MTOK) { npos = __hip_atomic_load((const unsigned long long*)tok_pos + m + NGW, RLX_AGENT); nw = __hip_atomic_load((const unsigned long long*)tok_w + m + NGW, RLX_AGENT); }
        if (p0 < 128 * 256 && p1 < 128 * 256) {
            u32x4 ya[4], yb[4], xw[4];
#pragma unroll
            for (int j = 0; j < 4; ++j) { const int d = 8 * F.lane + 512 * j; ya[j] = *(const u32x4*)(Y + (size_t)p0 * DM + d); yb[j] = *(const u32x4*)(Y + (size_t)p1 * DM + d); xw[j] = *(const u32x4*)((const bf16_t*)X + (size_t)m * DM + d); }
#pragma unroll
            for (int j = 0; j < 4; ++j) { const int d = 8 * F.lane + 512 * j;
                const f32x4 ga = *(const f32x4*)(g + d), gb = *(const f32x4*)(g + d + 4);
                const unsigned* pa = (const unsigned*)&ya[j]; const unsigned* pb = (const unsigned*)&yb[j]; const unsigned* px = (const unsigned*)&xw[j];
                f32x4 oa, ob;
#pragma unroll
                for (int i = 0; i < 2; ++i) {
                    oa[2 * i] = hf_lo(px[i]) + ga[2 * i] * (w0 * bf_lo(pa[i]) + w1 * bf_lo(pb[i])); oa[2 * i + 1] = hf_hi(px[i]) + ga[2 * i + 1] * (w0 * bf_hi(pa[i]) + w1 * bf_hi(pb[i]));
                    ob[2 * i] = hf_lo(px[2 + i]) + gb[2 * i] * (w0 * bf_lo(pa[2 + i]) + w1 * bf_lo(pb[2 + i])); ob[2 * i + 1] = hf_hi(px[2 + i]) + gb[2 * i + 1] * (w0 * bf_hi(pa[2 + i]) + w1 * bf_hi(pb[2 + i])); }
                *(f32x4*)(out + (size_t)m * DM + d) = oa * pf; *(f32x4*)(out + (size_t)m * DM + d + 4) = ob * pf; }
        } else {
#pragma unroll
        for (int j = 0; j < 4; ++j) { const int d = 8 * F.lane + 512 * j;
            float y0[8], y1[8]; moe_y8(Y, slabs, p0, d, S, ysc, y0); moe_y8(Y, slabs, p1, d, S, ysc, y1);
            f32x4 xa, xb; { const u32x4 xw = *(const u32x4*)((const bf16_t*)X + (size_t)m * DM + d); xa = (f32x4){hf_lo(xw.x), hf_hi(xw.x), hf_lo(xw.y), hf_hi(xw.y)}; xb = (f32x4){hf_lo(xw.z), hf_hi(xw.z), hf_lo(xw.w), hf_hi(xw.w)}; }
            const f32x4 ga = *(const f32x4*)(g + d), gb = *(const f32x4*)(g + d + 4);
            f32x4 oa, ob;
#pragma unroll
            for (int i = 0; i < 4; ++i) { oa[i] = xa[i] + ga[i] * (w0 * y0[i] + w1 * y1[i]); ob[i] = xb[i] + gb[i] * (w0 * y0[4 + i] + w1 * y1[4 + i]); }
            *(f32x4*)(out + (size_t)m * DM + d) = oa * pf; *(f32x4*)(out + (size_t)m * DM + d + 4) = ob * pf; } }
    }
}
static_assert(X_BF16 == 1, "combine_phase reads the residual stream as f16");

constexpr int N_PHASES = 18;
__global__ void __launch_bounds__(NWAVES * 64, 2) fwd_kernel(Args args) {
    extern __shared__ __attribute__((aligned(16))) unsigned char lds[];
    Frame F;
    F.lds = (LAS unsigned char*)lds; F.ldsg = (char*)lds;
    F.tid = threadIdx.x; F.lane = F.tid & 63; F.wave = __builtin_amdgcn_readfirstlane(F.tid >> 6);
    F.G = gridDim.x; { const int bx = blockIdx.x; F.vcu = (F.G % 8 == 0) ? (bx % 8) * (F.G / 8) + bx / 8 : bx; }
    F.ws = args.ws;
    unsigned char* ws = args.ws;
    volatile LAS unsigned* MISC = (volatile LAS unsigned*)(F.lds + MISC_OFF);
    for (int u = F.tid; u < (LDS_BYTES - PHASE_LDS) / 4; u += NWAVES * 64) ((LAS unsigned*)(F.lds + PHASE_LDS))[u] = 0u;
    __syncthreads();
    XcdBarrier bar; bar.bar = (unsigned*)(ws + WS_CTL) + CW_BAR; bar.x = 0; bar.st = nullptr;
    if (args.use_bar) bar = xcd_barrier_post((unsigned*)(ws + WS_CTL) + CW_BAR, MISC + 8);
    const int lo = args.ph_lo, hi = args.ph_hi;
#ifndef PHMASK
#define PHMASK 0x3ffff
#endif
#define IN(k) (((PHMASK >> (k)) & 1) && lo <= (k) && (k) < hi)
#define SEAM(k) do { if ((k) + 1 < hi) xcd_barrier(bar); } while (0)
#define FRESH() do { int t_ = threadIdx.x; asm volatile("" : "+v"(t_)); F.tid = t_; F.lane = t_ & 63; } while (0)
    float* mod = (float*)(ws + WS_MOD);
    float* kmean = (float*)(ws + WS_KMEAN);
    int* tok_e = (int*)(ws + WS_ROUTE); float* tok_w = (float*)(ws + WS_ROUTE + 131072); int* tok_rank = (int*)(ws + WS_ROUTE + 262144); int* tok_pos = (int*)(ws + WS_ROUTE + 393216);
    int* chunk_cnt = (int*)(ws + WS_CNT); int* mt_e = (int*)(ws + WS_CNT + 16384); int* n_mt = (int*)(ws + WS_CNT + 24576);
    float* rope = (float*)(ws + WS_ROPE);
    float* rsc = (float*)(ws + WS_RS);
    const float* wsc = (const float*)(ws + WS_WSC);
#define WSC_INV(t) (1.f / __builtin_bit_cast(float, ld_i32_agent((const int*)wsc + (t))))
    float* X = (float*)(ws + WS_X);
    unsigned char* ar = ws + WS_AR;
    bf16_t* H = (bf16_t*)(ar + A_H);
    const float* x_in = args.in[IN_X];

    if (IN(0)) { FRESH(); mod_phase(F, args.in[IN_C], args.in[IN_MODW], args.in[IN_MODB], mod); rope_table_phase(F, rope); { LAS float* wsc_l = (LAS float*)(F.lds + PHASE_LDS); calib_phase(F, args, wsc_l, (float*)(ws + WS_WSC)); convert_phase(F, args, wsc_l, 0, CVT_P0); } SEAM(0); }
    if (IN(1)) { FRESH(); norm_phase<MD_CONVIN>(F, x_in, args.in[IN_NMIX], mod, 0, H, rsc); SEAM(1); }
    if (IN(2)) { FRESH(); pg8::Gemm g{H, ws + WS_W1, DM * (MD_CONVIN ? 1 : 2), 0}; pg8::TileOrder S; S.init(MTOK / 256, 24, F.G, (int)blockIdx.x, nullptr, g.rowB / 128);
        pg8::EpiConvIn<MD_CONVIN == 2> E{(bf16_t*)(ar + A_U), (bf16_t*)(ar + A_BG), rsc, MD_CONVIN == 2 ? WSC_INV(WQ_CONVIN) : 1.f};
        const int kx = (((int)blockIdx.x & 7) * 6) / 7;
        { const pg8::SubOrder<pg8::TileOrder> S0{S, 0, kx}; pg8::gemm_phase<pg8::EpiConvIn<MD_CONVIN == 2>, pg8::SubOrder<pg8::TileOrder>, true, MD_CONVIN>(F.lds, g, S0, E); }
        FRESH(); cvt_slice(F, args, wsc, CVT_P0, CVT_S1); FRESH();
        { const pg8::SubOrder<pg8::TileOrder> S1{S, kx, 1 << 20}; pg8::gemm_phase<pg8::EpiConvIn<MD_CONVIN == 2>, pg8::SubOrder<pg8::TileOrder>, true, MD_CONVIN>(F.lds, g, S1, E); } SEAM(2); }
    if (IN(3)) { FRESH(); conv_phase(F, (const bf16_t*)(ar + A_U), (const bf16_t*)(ar + A_BG), args.in[IN_CONVW], (bf16_t*)(ar + A_W)); SEAM(3); }
#if X_BF16
#define RESID_T(f32base) pg8::EpiResidBf<f32base>
#define RESID_OUT (bf16_t*)X
#else
#define RESID_T(f32base) pg8::EpiResid
#define RESID_OUT X
#endif
    if (IN(4)) { FRESH(); pg8::Gemm g{ar + A_W, ws + WS_W2, DM * 2, 0}; pg8::TileOrder S; S.init(MTOK / 256, DM / 256, F.G, (int)blockIdx.x, nullptr, g.rowB / 128);
        RESID_T(true) E{x_in, RESID_OUT, mod + 2 * DM, 1.f};
        const int kx = (((int)blockIdx.x & 7) * 3) >> 3;
        { const pg8::SubOrder<pg8::TileOrder> S0{S, 0, kx}; pg8::gemm_phase<RESID_T(true), pg8::SubOrder<pg8::TileOrder>, true>(F.lds, g, S0, E); }
        FRESH(); cvt_slice(F, args, wsc, CVT_S1, CVT_S1B); FRESH();
        { const pg8::SubOrder<pg8::TileOrder> S1{S, kx, 1 << 20}; pg8::gemm_phase<RESID_T(true), pg8::SubOrder<pg8::TileOrder>, true>(F.lds, g, S1, E); } SEAM(4); }
    if (IN(5)) { FRESH(); norm_phase<MD_FFN_GU, X_BF16 != 0>(F, X, args.in[IN_NFFN], mod, 3, H, rsc); SEAM(5); }
    if (IN(6)) { FRESH(); constexpr int EB = MD_FFN_GU ? 1 : 2; pg8::Gemm g{H, ws + WS_W3, DM * EB, 0}; pg8::TileOrder S; S.init(MTOK / 256, 2 * FF / 256, F.G, (int)blockIdx.x, nullptr, g.rowB / 128);
        const float ig = MD_FFN_GU == 2 ? WSC_INV(WQ_FGATE) : (MD_FFN_GU == 1 ? 1.f / (HS_SCALE * W_SCALE) : 1.f), iu = MD_FFN_GU == 2 ? WSC_INV(WQ_FUP) : ig;
        pg8::EpiSwiglu<F8_FFN_DN != 0, MD_FFN_GU == 2, F8_FFN_DN != 0> E{ar + A_HID, FF, ig, HID_SCALE, rsc, iu};
        const int kx = (((int)blockIdx.x & 7) * 11) / 7;
        { const pg8::SubOrder<pg8::TileOrder> S0{S, 0, kx}; pg8::gemm_phase<pg8::EpiSwiglu<F8_FFN_DN != 0, MD_FFN_GU == 2, F8_FFN_DN != 0>, pg8::SubOrder<pg8::TileOrder>, true, MD_FFN_GU>(F.lds, g, S0, E); }
        FRESH(); cvt_slice(F, args, wsc, CVT_S1B, CVT_S2); FRESH();
        { const pg8::SubOrder<pg8::TileOrder> S1{S, kx, 1 << 20}; pg8::gemm_phase<pg8::EpiSwiglu<F8_FFN_DN != 0, MD_FFN_GU == 2, F8_FFN_DN != 0>, pg8::SubOrder<pg8::TileOrder>, true, MD_FFN_GU>(F.lds, g, S1, E); } SEAM(6); }
    if (IN(7)) { FRESH(); constexpr int EB = F8_FFN_DN ? 1 : 2; pg8::Gemm g{ar + A_HID, ws + WS_W4, FF * EB, 0}; pg8::TileOrder S; S.init(MTOK / 256, DM / 256, F.G, (int)blockIdx.x, nullptr, g.rowB / 128);
        RESID_T(false) E{X, RESID_OUT, mod + 5 * DM, F8_FFN_DN ? 1.f / (HID_SCALE * W_SCALE) : 1.f};
        const int kx = (((int)blockIdx.x & 7) * 3) >> 3;
        { const pg8::SubOrder<pg8::TileOrder> S0{S, 0, kx}; pg8::gemm_phase<RESID_T(false), pg8::SubOrder<pg8::TileOrder>, true, F8_FFN_DN != 0, F8_FFN_DN != 0>(F.lds, g, S0, E); }
        FRESH(); cvt_slice(F, args, wsc, CVT_S2, CVT_S2B); FRESH();
        { const pg8::SubOrder<pg8::TileOrder> S1{S, kx, 1 << 20}; pg8::gemm_phase<RESID_T(false), pg8::SubOrder<pg8::TileOrder>, true, F8_FFN_DN != 0, F8_FFN_DN != 0>(F.lds, g, S1, E); } SEAM(7); }
    const float* mod1 = mod + (size_t)NB * 6 * DM;
    if (IN(8)) { FRESH(); norm_phase<MD_QKV, X_BF16 != 0>(F, X, args.in[IN_NMIX] + DM, mod1, 0, H, rsc); SEAM(8); }
    if (IN(9)) { FRESH(); constexpr int EB = MD_QKV ? 1 : 2; pg8::Gemm g{H, ws + WS_W5, DM * EB, 0}; pg8::TileOrder S; S.init(MTOK / 256, 24, F.G, (int)blockIdx.x, nullptr, g.rowB / 128);
        const float qsc = MD_QKV == 2 ? WSC_INV(WQ_QKV) : (MD_QKV == 1 ? 1.f / (HS_SCALE * W_SCALE) : 1.f);
#if QK_FUSED
        pg8::EpiQKV<MD_QKV == 2> E{(bf16_t*)(ar + A_QKV), qsc, rsc, args.in[IN_QNORM], args.in[IN_KNORM], rope, kmean, (LAS float*)(F.lds + RING_BYTES)};
        const int kx = (((int)blockIdx.x & 7) * 6) / 7;
        { const pg8::SubOrder<pg8::TileOrder> S0{S, 0, kx}; pg8::gemm_phase<pg8::EpiQKV<MD_QKV == 2>, pg8::SubOrder<pg8::TileOrder>, true, MD_QKV>(F.lds, g, S0, E); }
        FRESH(); cvt_slice(F, args, wsc, CVT_S2B, CVT_S3); FRESH();
        { const pg8::SubOrder<pg8::TileOrder> S1{S, kx, 1 << 20}; pg8::gemm_phase<pg8::EpiQKV<MD_QKV == 2>, pg8::SubOrder<pg8::TileOrder>, true, MD_QKV>(F.lds, g, S1, E); } SEAM(9); }
#else
        pg8::EpiBf16T<MD_QKV == 2> E{(bf16_t*)(ar + A_QKV), 6144, qsc, rsc};
        pg8::gemm_phase<pg8::EpiBf16T<MD_QKV == 2>, pg8::TileOrder, true, MD_QKV>(F.lds, g, S, E); SEAM(9); }
#endif
#if !QK_FUSED
    if (IN(10)) { FRESH(); qkprep_phase(F, (bf16_t*)(ar + A_QKV), args.in[IN_QNORM], args.in[IN_KNORM], rope, kmean); SEAM(10); }
#endif
    if (IN(11)) { FRESH(); const int kx = (((int)blockIdx.x & 7) * 3) >> 3;
        attn_phase(F, (const bf16_t*)(ar + A_QKV), ar + A_O, kmean, 0, kx);
        FRESH(); cvt_slice(F, args, wsc, CVT_S3, CVT_NITEMS); FRESH();
        attn_phase(F, (const bf16_t*)(ar + A_QKV), ar + A_O, kmean, kx, 1 << 20); SEAM(11);
#ifdef ATTN_PROBE
        FRESH(); attn_probe_phase(F, (const bf16_t*)(ar + A_QKV), (const bf16_t*)(ar + A_O), kmean, (unsigned*)(ws + WS_CTL)); xcd_barrier(bar);
#endif
    }
    if (IN(12)) { FRESH(); constexpr int EB = F8_AOUT ? 1 : 2; pg8::Gemm g{ar + A_O, ws + WS_W6, DM * EB, 0}; pg8::TileOrder S; S.init(MTOK / 256, DM / 256, F.G, (int)blockIdx.x, nullptr, g.rowB / 128);
        RESID_T(false) E{X, RESID_OUT, mod1 + 2 * DM, F8_AOUT ? 1.f / (O_SCALE * W_SCALE) : 1.f};
        pg8::gemm_phase<RESID_T(false), pg8::TileOrder, true, F8_AOUT != 0>(F.lds, g, S, E); SEAM(12); }
    if (IN(13)) { FRESH(); norm_router_phase(F, X, args.in[IN_NFFN] + DM, mod1, args.in[IN_RW], args.in[IN_RB], H, tok_e, tok_w, tok_rank, chunk_cnt, (float*)(ws + WS_RS2)); SEAM(13); }
    if (IN(14)) { FRESH(); scatter_phase(F, chunk_cnt, tok_e, tok_rank, tok_pos, H, ar + A_HS, mt_e, n_mt, rsc, (const float*)(ws + WS_RS2)); SEAM(14); }
    if (IN(15)) { FRESH(); const int nmt = ld_i32_agent(n_mt);
        constexpr int EB = MD_MOE_GU ? 1 : 2;
        LAS int* mtl = (LAS int*)(F.lds + RING_BYTES); for (int i = F.tid; i < MT_MAX; i += NWAVES * 64) mtl[i] = ld_i32_agent(mt_e + i); __syncthreads();
        pg8::Gemm g{ar + A_HS, ws + WS_W7, DM * EB, (size_t)2 * FFE * DM * EB}; pg8::TileOrder S; S.init(nmt, 2 * FFE / 256, F.G, (int)blockIdx.x, mtl, g.rowB / 128);
        const float ig = MD_MOE_GU == 2 ? WSC_INV(WQ_EGATE) : (MD_MOE_GU == 1 ? 1.f / (HS_SCALE * W_SCALE) : 1.f), iu = MD_MOE_GU == 2 ? WSC_INV(WQ_EUP) : ig;
        pg8::EpiSwiglu<MOE_F8 != 0, MD_MOE_GU == 2, MOE_F8 != 0> E{ar + A_HID2, FFE, ig, HID_SCALE, rsc, iu};
        pg8::gemm_phase<pg8::EpiSwiglu<MOE_F8 != 0, MD_MOE_GU == 2, MOE_F8 != 0>, pg8::TileOrder, true, MD_MOE_GU>(F.lds, g, S, E); SEAM(15); }
    if (IN(16)) { FRESH(); const int nmt = ld_i32_agent(n_mt);
        constexpr int EB = MOE_F8 ? 1 : 2;
        pg8::Gemm g{ar + A_HID2, ws + WS_W8, FFE * EB, (size_t)DM * FFE * EB};
        LAS int* mtl = (LAS int*)(F.lds + RING_BYTES); for (int i = F.tid; i < MT_MAX; i += NWAVES * 64) mtl[i] = ld_i32_agent(mt_e + i); __syncthreads();
        { pg8::TileOrder S; S.init(128, DM / 256, F.G, (int)blockIdx.x, mtl, g.rowB / 128);
          pg8::EpiBf16 E{(bf16_t*)(ar + A_Y), DM, MOE_F8 ? 1.f / (HID_SCALE * W_SCALE) : 1.f, nullptr};
          pg8::gemm_phase<pg8::EpiBf16, pg8::TileOrder, true, MOE_F8 != 0, MOE_F8 != 0>(F.lds, g, S, E); }
        { pg8::PieceOrder S; S.init(nmt, DM / 256, F.G, (int)blockIdx.x, mt_e, g.rowB / 128);
          pg8::EpiSlab E{(float*)(ar + A_SLAB)};
          pg8::gemm_phase<pg8::EpiSlab, pg8::PieceOrder, true, MOE_F8 != 0, MOE_F8 != 0>(F.lds, g, S, E); }
        SEAM(16); }
#ifdef ATTN_PROBE
    if (IN(17)) { FRESH(); const unsigned* ctl = (const unsigned*)(ws + WS_CTL); const float pf = 1.0f + ATTN_PROBE_GAIN * (ATTN_PROBE == 1 ? __uint_as_float(__hip_atomic_load(ctl + 8, RLX_AGENT)) : (float)__hip_atomic_load(ctl + 9, RLX_AGENT) * (1.0f / 8192.0f));
        const int nmt = ld_i32_agent(n_mt); combine_phase(F, X, mod1 + 5 * DM, (const bf16_t*)(ar + A_Y), (const float*)(ar + A_SLAB), pg8::moe_split(nmt, DM / 256, F.G, FFE * (MOE_F8 ? 1 : 2) / 128), MOE_F8 ? 1.f / (HID_SCALE * W_SCALE) : 1.f, tok_pos, tok_w, args.out, pf); }
#else
    if (IN(17)) { FRESH(); const int nmt = ld_i32_agent(n_mt); combine_phase(F, X, mod1 + 5 * DM, (const bf16_t*)(ar + A_Y), (const float*)(ar + A_SLAB), pg8::moe_split(nmt, DM / 256, F.G, FFE * (MOE_F8 ? 1 : 2) / 128), MOE_F8 ? 1.f / (HID_SCALE * W_SCALE) : 1.f, tok_pos, tok_w, args.out); }
#endif
#undef IN
#undef SEAM
}

extern "C" void kernel_launch(void* const* d_in, const int* in_sizes, int n_in, void* d_out, int out_size, void* d_ws, size_t ws_size, hipStream_t stream) {
    static int grid = 0;
    if (grid == 0) {
        if (n_in != N_IN || out_size != MTOK * DM || ws_size < WS_END) { fprintf(stderr, "kernel_launch: unexpected shapes (n_in %d, out %d, ws %zu)\n", n_in, out_size, ws_size); grid = -1; return; }
        int dev = 0, cus = 0, per_cu = 0;
        if (hipGetDevice(&dev) != hipSuccess || hipDeviceGetAttribute(&cus, hipDeviceAttributeMultiprocessorCount, dev) != hipSuccess) { grid = -1; return; }
        if (hipFuncSetAttribute((const void*)fwd_kernel, hipFuncAttributeMaxDynamicSharedMemorySize, LDS_BYTES) != hipSuccess) { fprintf(stderr, "kernel_launch: hipFuncSetAttribute failed\n"); grid = -1; return; }
        if (hipOccupancyMaxActiveBlocksPerMultiprocessor(&per_cu, (const void*)fwd_kernel, NWAVES * 64, LDS_BYTES) != hipSuccess || per_cu < 1) { fprintf(stderr, "kernel_launch: occupancy query says %d\n", per_cu); }
        (void)hipGetLastError();
        grid = cus;
    }
    if (grid < 0) return;
    (void)hipMemsetAsync((char*)d_ws + WS_CTL, 0, CTL_ZERO_BYTES, stream);
    Args a{};
    for (int i = 0; i < N_IN; ++i) a.in[i] = (const float*)d_in[i];
    a.out = (float*)d_out; a.ws = (unsigned char*)d_ws; a.pad = 0;
#if MK_PER_PHASE
    for (int p = 0; p < N_PHASES; ++p) { a.ph_lo = p; a.ph_hi = p + 1; a.use_bar = 0;
        hipLaunchKernelGGL(fwd_kernel, dim3(grid), dim3(NWAVES * 64), LDS_BYTES, stream, a); }
#else
    a.ph_lo = 0; a.ph_hi = N_PHASES; a.use_bar = 1;
    hipLaunchKernelGGL(fwd_kernel, dim3(grid), dim3(NWAVES * 64), LDS_BYTES, stream, a);
#endif
}
```
